# Optimizing an MI355X kernel written in HIP

```python
import jax, jax.numpy as jnp
from jax import lax
import numpy as np

D_MODEL = 2048
BATCH = 4
SEQ = 4096
DEPTH = 1

CHUNK = 64
EPS = 1e-6
PLE_DIM = 256
POOL_WINDOWS = (2, 4, 8, 16)
POOL_WIDTH = D_MODEL // 2
POOL_GROUP_DIM = POOL_WIDTH // len(POOL_WINDOWS)
SGU_BLOCK = 128
SGU_GROUPS = 8
SGU_WIDTH = D_MODEL // 2
SGU_GROUP_DIM = SGU_WIDTH // SGU_GROUPS
N_IN = POOL_WIDTH + 2 * SGU_WIDTH
N_EXPERT_GROUPS = 4
EXPERTS_PER_GROUP = 8
N_EXPERTS = N_EXPERT_GROUPS * EXPERTS_PER_GROUP
TOP_K_EXPERT = 2
D_EXPERT = D_MODEL // 4
MOE_BLOCK_ROWS = 256

kernel_name = "hybrid_pool_sgu_hmoe_block"


def _rmsnorm(x, g):
    xf = x.astype(jnp.float32)
    y = xf * lax.rsqrt(jnp.mean(xf * xf, axis=-1, keepdims=True) + EPS)
    return (y * g.astype(jnp.float32)).astype(x.dtype)


def _layernorm(x, g, b):
    xf = x.astype(jnp.float32)
    mu = jnp.mean(xf, axis=-1, keepdims=True)
    xc = xf - mu
    var = jnp.mean(xc * xc, axis=-1, keepdims=True)
    y = xc * lax.rsqrt(var + EPS) * g.astype(jnp.float32) + b.astype(jnp.float32)
    return y.astype(x.dtype)


def _pool_mixer(a, w_pool, pool_scale):
    bsz, s, _ = a.shape
    af = a.astype(jnp.float32)
    cs = jnp.cumsum(af, axis=1)
    t = jnp.arange(1, s + 1, dtype=jnp.float32)
    outs = []
    for gi, w in enumerate(POOL_WINDOWS):
        lo, hi = gi * POOL_GROUP_DIM, (gi + 1) * POOL_GROUP_DIM
        cs_g = cs[:, :, lo:hi]
        prev = jnp.pad(cs_g[:, : s - w], ((0, 0), (w, 0), (0, 0)))
        cnt = jnp.minimum(t, w)[None, :, None]
        outs.append((cs_g - prev) / cnt - af[:, :, lo:hi])
    z = jnp.stack(outs, axis=2).astype(a.dtype)
    y = jnp.einsum('bsgc,gcd->bsgd', z, w_pool).reshape(bsz, s, POOL_WIDTH)
    return y * pool_scale


def _spatial_gating(u, v, ln_g, ln_b, w_spatial, b_spatial):
    bsz, s, _ = u.shape
    u = jax.nn.gelu(u)
    v = _layernorm(jax.nn.gelu(v), ln_g, ln_b)
    nblk = s // SGU_BLOCK
    vb = v.reshape(bsz, nblk, SGU_BLOCK, SGU_GROUPS, SGU_GROUP_DIM)
    pos_chunk = jnp.arange(SGU_BLOCK) // CHUNK
    mask = pos_chunk[None, :] <= pos_chunk[:, None]
    ws = jnp.where(mask[None], w_spatial, 0.0)
    vm = jnp.einsum('gts,bnsgc->bntgc', ws, vb) + b_spatial.T[None, None, :, :, None]
    return u * vm.reshape(bsz, s, SGU_WIDTH)


def _hier_moe(h, w_rg, b_rg, w_re, b_re, w_g, w_u, w_d):
    bsz, s, d = h.shape
    n_tok = bsz * s
    hf = h.reshape(n_tok, d)
    grp_logits = (hf @ w_rg).astype(jnp.float32) + b_rg.astype(jnp.float32)
    grp_prob = jax.nn.softmax(grp_logits, axis=-1)
    grp_p, grp_idx = lax.top_k(grp_prob, 1)
    exp_logits = jnp.einsum('td,gde->tge', hf, w_re).astype(jnp.float32) + b_re.astype(jnp.float32)
    sel = jnp.take_along_axis(exp_logits, grp_idx[:, :, None], axis=1)[:, 0]
    top_logit, top_loc = lax.top_k(sel, TOP_K_EXPERT)
    weights = grp_p * jax.nn.softmax(top_logit, axis=-1)
    expert_id = grp_idx * EXPERTS_PER_GROUP + top_loc

    n_assign = n_tok * TOP_K_EXPERT
    n_blocks = -(-n_assign // MOE_BLOCK_ROWS) + N_EXPERTS
    n_rows = n_blocks * MOE_BLOCK_ROWS
    flat_e = expert_id.reshape(-1).astype(jnp.int32)
    flat_tok = jnp.repeat(jnp.arange(n_tok, dtype=jnp.int32), TOP_K_EXPERT)
    flat_w = weights.reshape(-1)
    order = jnp.argsort(flat_e)
    se, st, sw = flat_e[order], flat_tok[order], flat_w[order]
    counts = jnp.bincount(flat_e, length=N_EXPERTS)
    padded = (counts + MOE_BLOCK_ROWS - 1) // MOE_BLOCK_ROWS * MOE_BLOCK_ROWS
    pad_end = jnp.cumsum(padded)
    pad_start = pad_end - padded
    start = jnp.cumsum(counts) - counts
    dest = pad_start[se] + jnp.arange(n_assign, dtype=jnp.int32) - start[se]
    row_tok = jnp.full((n_rows,), n_tok, jnp.int32).at[dest].set(st)
    row_w = jnp.zeros((n_rows,), jnp.float32).at[dest].set(sw)
    block_start = jnp.arange(n_blocks, dtype=jnp.int32) * MOE_BLOCK_ROWS
    block_e = jnp.minimum(jnp.searchsorted(pad_end, block_start, side='right'), N_EXPERTS - 1)
    h_pad = jnp.concatenate([hf, jnp.zeros((1, d), hf.dtype)], axis=0)

    def expert_rows(args):
        e, tok, wt = args
        xb = h_pad[tok]
        hid = jax.nn.silu(xb @ w_g[e]) * (xb @ w_u[e])
        return (hid @ w_d[e]) * wt[:, None].astype(xb.dtype)

    ys = lax.map(expert_rows, (block_e, row_tok.reshape(n_blocks, MOE_BLOCK_ROWS),
                               row_w.reshape(n_blocks, MOE_BLOCK_ROWS)))
    out = jax.ops.segment_sum(ys.reshape(n_rows, d), row_tok, num_segments=n_tok + 1)[:n_tok]
    return out.reshape(bsz, s, d).astype(h.dtype)


def setup_inputs(seed: int = 0) -> dict:
    key = jax.random.key(seed)
    ks = jax.random.split(key, 32)
    L, D = DEPTH, D_MODEL

    def nrm(k, shape, fan_in):
        return jax.random.normal(k, shape, jnp.float32) * (fan_in ** -0.5)

    def gain(k, shape):
        return 1.0 + 0.02 * jax.random.normal(k, shape, jnp.float32)

    def bias(k, shape, scale=0.02):
        return scale * jax.random.normal(k, shape, jnp.float32)

    return {
        "x": jax.random.normal(ks[0], (BATCH, SEQ, D), jnp.float32),
        "p": jax.random.normal(ks[1], (DEPTH, BATCH, SEQ, PLE_DIM), jnp.float32),
        "g_mix": gain(ks[2], (L, D)),
        "w_in": nrm(ks[3], (L, D, N_IN), D),
        "w_pool": nrm(ks[4], (L, len(POOL_WINDOWS), POOL_GROUP_DIM, POOL_GROUP_DIM), POOL_GROUP_DIM),
        "pool_scale": gain(ks[5], (L, POOL_WIDTH)),
        "w_branch_a": nrm(ks[6], (L, POOL_WIDTH, D), POOL_WIDTH),
        "sgu_ln_g": gain(ks[7], (L, SGU_WIDTH)),
        "sgu_ln_b": bias(ks[8], (L, SGU_WIDTH)),
        "w_spatial": nrm(ks[9], (L, SGU_GROUPS, SGU_BLOCK, SGU_BLOCK), SGU_BLOCK),
        "b_spatial": gain(ks[10], (L, SGU_GROUPS, SGU_BLOCK)),
        "w_branch_b": nrm(ks[11], (L, SGU_WIDTH, D), SGU_WIDTH),
        "w_merge_gate": nrm(ks[12], (L, D, 2 * D), D),
        "b_merge_gate": bias(ks[13], (L, 2 * D)),
        "w_out": nrm(ks[14], (L, D, D), D),
        "g_ffn": gain(ks[15], (L, D)),
        "w_router_group": nrm(ks[16], (L, D, N_EXPERT_GROUPS), D),
        "b_router_group": bias(ks[17], (L, N_EXPERT_GROUPS), 0.01),
        "w_router_expert": nrm(ks[18], (L, N_EXPERT_GROUPS, D, EXPERTS_PER_GROUP), D),
        "b_router_expert": bias(ks[19], (L, N_EXPERT_GROUPS, EXPERTS_PER_GROUP), 0.01),
        "w_exp_gate": nrm(ks[20], (L, N_EXPERTS, D, D_EXPERT), D),
        "w_exp_up": nrm(ks[21], (L, N_EXPERTS, D, D_EXPERT), D),
        "w_exp_down": nrm(ks[22], (L, N_EXPERTS, D_EXPERT, D), D_EXPERT),
        "g_ple": gain(ks[23], (L, D)),
        "w_ple_gate": nrm(ks[24], (L, D, D), D),
        "b_ple_gate": bias(ks[25], (L, D)),
        "w_ple_up": nrm(ks[26], (L, PLE_DIM, D), PLE_DIM),
        "g_final": gain(ks[27], (D,)),
    }


def reference(x, p, g_mix, w_in, w_pool, pool_scale, w_branch_a, sgu_ln_g, sgu_ln_b, w_spatial,
              b_spatial, w_branch_b, w_merge_gate, b_merge_gate, w_out, g_ffn, w_router_group,
              b_router_group, w_router_expert, b_router_expert, w_exp_gate, w_exp_up, w_exp_down,
              g_ple, w_ple_gate, b_ple_gate, w_ple_up, g_final):
    for i in range(DEPTH):
        h = _rmsnorm(x, g_mix[i])
        z = h @ w_in[i]
        a_in = z[..., :POOL_WIDTH]
        u = z[..., POOL_WIDTH:POOL_WIDTH + SGU_WIDTH]
        v = z[..., POOL_WIDTH + SGU_WIDTH:]
        y_a = _pool_mixer(a_in, w_pool[i], pool_scale[i]) @ w_branch_a[i]
        y_b = _spatial_gating(u, v, sgu_ln_g[i], sgu_ln_b[i], w_spatial[i], b_spatial[i]) @ w_branch_b[i]
        gates = jax.nn.sigmoid(h @ w_merge_gate[i] + b_merge_gate[i])
        merged = gates[..., :D_MODEL] * y_a + gates[..., D_MODEL:] * y_b
        x = x + merged @ w_out[i]
        x = x + _hier_moe(_rmsnorm(x, g_ffn[i]), w_router_group[i], b_router_group[i],
                          w_router_expert[i], b_router_expert[i], w_exp_gate[i], w_exp_up[i], w_exp_down[i])
        gate_p = jax.nn.sigmoid(_rmsnorm(x, g_ple[i]) @ w_ple_gate[i] + b_ple_gate[i])
        x = x + gate_p * (p[i] @ w_ple_up[i])
    return _rmsnorm(x, g_final)
```

```cpp
#include <hip/hip_runtime.h>
#include <stdint.h>
#include <stdio.h>

typedef unsigned short bf16_t;
#define DEV __device__ __forceinline__

DEV float bf2f(bf16_t v) { return __uint_as_float(((unsigned)v) << 16); }
DEV bf16_t f2bf(float f) { unsigned u = __float_as_uint(f); return (bf16_t)((u + 0x7fffu + ((u >> 16) & 1u)) >> 16); }
DEV float sigmoidf_(float x) { return 1.f / (1.f + __expf(-x)); }
DEV float gelu_tanh(float x) { const float u = 0.7978845608028654f * (x + 0.044715f * x * x * x); return x / (1.f + __expf(-2.f * u)); }
DEV float silu_(float x) { return x / (1.f + __expf(-x)); }

constexpr int T = 16384, D = 2048, SEQ = 4096, NIN = 3072, N1 = 7168, PW = 1024, SW = 1024, NE = 32, DE = 512, PLE = 256;
constexpr int CAP = 16384;
constexpr float EPS = 1e-6f;
constexpr float WGU_SCALE = 256.f, WD_SCALE = 128.f, HID_SCALE = 8.f, Y_SCALE = 16.f;

constexpr size_t MiB = 1u << 20;
constexpr size_t WS_CTL = 0;
constexpr size_t WS_SSQ = 256 * 1024;
constexpr size_t WS_PCNT = 512 * 1024;
constexpr size_t WS_MOERDY = 768 * 1024;
constexpr size_t WS_EID = 1 * MiB;
constexpr size_t WS_EW = 2 * MiB;
constexpr size_t WS_RSTD = 3 * MiB;
constexpr size_t WS_RSTD0 = 3 * MiB + 256 * 1024;
constexpr size_t WS_RSTD2 = 3 * MiB + 512 * 1024;
constexpr size_t WS_LIST = 4 * MiB;
constexpr size_t WS_WRH = 6 * MiB;
constexpr size_t WS_WRL = 7 * MiB;
constexpr size_t WS_W1T = 8 * MiB;
constexpr size_t WS_LNS = 20 * MiB;
constexpr size_t WS_W2T = 24 * MiB;
constexpr size_t WS_WPS = 30 * MiB;
constexpr size_t WS_WPT = 36 * MiB;
constexpr size_t WS_WSB = 36 * MiB + 512 * 1024;
constexpr size_t WS_WAT = 37 * MiB;
constexpr size_t WS_WBT = 41 * MiB;
constexpr size_t WS_WOT = 45 * MiB;
constexpr size_t WS_WPGT = 53 * MiB;
constexpr size_t WS_WPUT = 61 * MiB;
constexpr size_t WS_WGUT = 62 * MiB;
constexpr size_t WS_WDT = 190 * MiB;
constexpr size_t WS_PB = 254 * MiB;
constexpr size_t WS_XN = 262 * MiB;
constexpr size_t WS_AIN = 326 * MiB;
constexpr size_t WS_UU = 358 * MiB;
constexpr size_t WS_GV = 390 * MiB;
constexpr size_t WS_GATES = 422 * MiB;
constexpr size_t WS_MG = WS_AIN;
constexpr size_t WS_HID = WS_GV;
constexpr size_t WS_Y = WS_GATES;
constexpr size_t WS_X2B = WS_WGUT + 64 * MiB;
constexpr size_t WS_X2Q = WS_WDT + 32 * MiB;
constexpr size_t WS_XNQ = WS_X2B;
constexpr size_t WS_WMGQ = WS_X2Q;
constexpr size_t WS_END = 550 * MiB;
constexpr size_t OUT_X2B = 32 * MiB, OUT_X2Q = 96 * MiB;

#define LAS __attribute__((address_space(3)))
#define GAS __attribute__((address_space(1)))
typedef short bf16x8 __attribute__((ext_vector_type(8)));
typedef float f32x4 __attribute__((ext_vector_type(4)));
typedef float f32x2 __attribute__((ext_vector_type(2)));
typedef unsigned u32x4 __attribute__((ext_vector_type(4)));
typedef unsigned u32x2 __attribute__((ext_vector_type(2)));

namespace pg8 {
constexpr int BM = 256, BK = 64, HALF = 128, HTB = HALF * BK * 2, STAGE_BYTES = 8 * HTB, NXCD = 8, WGM = 8;
__host__ __device__ __forceinline__ int lds_byte(int r, int c) { const int st = (r >> 4) * 2 + (c >> 5), rr = r & 15, cc = c & 31, ob = rr * 64 + cc * 2; return st * 1024 + (ob ^ (((ob >> 9) & 1) << 5)); }
__host__ __device__ __forceinline__ void stage_rc(int b, int& R, int& C) { const int st = b / 1024, sb = b % 1024, swz = sb ^ (((sb >> 9) & 1) << 5); R = (st >> 1) * 16 + swz / 64; C = (st & 1) * 32 + (swz % 64) / 2; }
__host__ __device__ __forceinline__ int perm32(int rho) { const int n = rho >> 4, i = rho & 15; return 8 * (i >> 2) + 4 * n + (i & 3); }

enum { U_KEEP = 1 };
struct Unit { unsigned A; unsigned B; const int* rows; int pm, pn, flags, mvalid; };

DEV bool static_tile(int i, int G, int c, int nM, int nN, int& pm, int& pn) {
    const int nwg = nM * nN; const long L = (long)i * G + c; if (L >= nwg) return false;
    int wgid = (int)L; { const int q = nwg / NXCD, r = nwg % NXCD, xcd = wgid % NXCD, off = wgid / NXCD; wgid = (xcd < r ? xcd * (q + 1) : r * (q + 1) + (xcd - r) * q) + off; }
    const int nig = WGM * nN, gid = wgid / nig, fm = gid * WGM, gsz = (nM - fm) < WGM ? (nM - fm) : WGM;
    pm = fm + ((wgid % nig) % gsz); pn = (wgid % nig) / gsz; return true;
}
DEV unsigned cvt_pk_bf16(float lo, float hi) { unsigned r; asm volatile("v_cvt_pk_bf16_f32 %0, %1, %2" : "=v"(r) : "v"(lo), "v"(hi)); return r; }
DEV float fast_rcp(float x) { return __builtin_amdgcn_rcpf(x); }
DEV float fast_exp(float x) { return __builtin_amdgcn_exp2f(x * 1.4426950408889634f); }
DEV float sigm(float x) { return fast_rcp(1.f + fast_exp(-x)); }
DEV float gelu_t(float x) { const float u = 1.5957691216057308f * (x + 0.044715f * x * x * x); return x * fast_rcp(1.f + fast_exp(-u)); }
DEV float silu_f(float x) { return x * fast_rcp(1.f + fast_exp(-x)); }
typedef int i32x8 __attribute__((ext_vector_type(8)));
typedef int i32x4 __attribute__((ext_vector_type(4)));
DEV unsigned pk4_fp8(float a, float b, float c, float d) { int w = __builtin_amdgcn_cvt_pk_fp8_f32(a, b, 0, false); w = __builtin_amdgcn_cvt_pk_fp8_f32(c, d, w, true); return (unsigned)w; }
DEV float clamp448(float v) { return __builtin_fminf(__builtin_fmaxf(v, -448.f), 448.f); }

template <class Epi, class Sched, bool ALIGN_EPI, bool GATHER, bool FP8 = false>
DEV void gemm_phase(LAS unsigned char* lds, const void* Abase, const void* Bbase, const unsigned lda, const unsigned ldb, const int nt_in, const int gshift, const Sched& S, const Epi& E, const int tid) {
    int nt = nt_in; asm volatile("" : "+s"(nt));
    const int wid = __builtin_amdgcn_readfirstlane(tid >> 6), lane = tid & 63, wr = wid >> 2, wc = wid & 3, fr = lane & 15, fq = lane >> 4;
    unsigned voffA[2], voffB[2];
#pragma unroll
    for (int i = 0; i < 2; ++i) { int R, C; stage_rc(tid * 16 + i * 8192, R, C); const int Rb = Epi::PERM ? ((R & ~31) + perm32(R & 31)) : R;
        voffA[i] = (unsigned)R * lda + (unsigned)C * 2u; voffB[i] = (unsigned)Rb * ldb + (unsigned)C * 2u; }
    const unsigned kstep = BK * 2u;
    const unsigned hstepA = HALF * lda, hstepB = HALF * ldb;
    const __amdgpu_buffer_rsrc_t rA = __builtin_amdgcn_make_buffer_rsrc(const_cast<void*>(Abase), 0, 0x7fffffff, 0x00020000), rB = __builtin_amdgcn_make_buffer_rsrc(const_cast<void*>(Bbase), 0, 0x7fffffff, 0x00020000);
    const unsigned ldsw = (unsigned)wid * 1024u;
    const int aoff = lds_byte(wr * 64 + fr, fq * 8), boff = lds_byte(wc * 32 + fr, fq * 8);
#define PG8_SA(b, h) (((b) * 2 + (h)) * HTB)
#define PG8_SB(b, h) ((4 + (b) * 2 + (h)) * HTB)
#define PG8_STG(bufoff, rs, voff, soff) do { _Pragma("unroll") for (int _i = 0; _i < 2; ++_i) \
        __builtin_amdgcn_raw_ptr_buffer_load_lds(rs, (LAS void*)(lds + (bufoff) + ldsw + _i * 8192), 16, (int)(voff)[_i], (int)(soff), 0, 0); } while (0)
#define PG8_STAGE_B(bufoff, soff) PG8_STG(bufoff, rB, voffB, soff)
#define PG8_STAGE_A(bufoff, soff, h) do { if constexpr (GATHER) { PG8_STG(bufoff, rA, gAc[h], soff); } else { PG8_STG(bufoff, rA, voffA, (soff) + (h) * hstepA); } } while (0)
#define PG8_LDA(dst, b, h) do { _Pragma("unroll") for (int m = 0; m < 4; ++m) _Pragma("unroll") for (int k = 0; k < 2; ++k) dst[m][k] = *(const LAS bf16x8*)(lds + PG8_SA(b, h) + aoff + m * 2048 + k * 1024); } while (0)
#define PG8_LDB(dst, b, h) do { _Pragma("unroll") for (int n = 0; n < 2; ++n) _Pragma("unroll") for (int k = 0; k < 2; ++k) dst[n][k] = *(const LAS bf16x8*)(lds + PG8_SB(b, h) + boff + n * 2048 + k * 1024); } while (0)
#define PG8_CAT(x, y) __builtin_shufflevector(__builtin_bit_cast(i32x4, x), __builtin_bit_cast(i32x4, y), 0, 1, 2, 3, 4, 5, 6, 7)
#define PG8_MMA(ai, bj, At, Bt) do { __builtin_amdgcn_s_setprio(1); _Pragma("unroll") for (int m = 0; m < 4; ++m) _Pragma("unroll") for (int n = 0; n < 2; ++n) { \
        if constexpr (FP8) acc[ai][bj][m][n] = __builtin_amdgcn_mfma_scale_f32_16x16x128_f8f6f4(PG8_CAT(Bt[n][0], Bt[n][1]), PG8_CAT(At[m][0], At[m][1]), acc[ai][bj][m][n], 0, 0, 0, 0, 0, 0); \
        else { _Pragma("unroll") for (int k = 0; k < 2; ++k) acc[ai][bj][m][n] = __builtin_amdgcn_mfma_f32_16x16x32_bf16(Bt[n][k], At[m][k], acc[ai][bj][m][n], 0, 0, 0); } } __builtin_amdgcn_s_setprio(0); } while (0)
#define PG8_WAIT_V(n) asm volatile("s_waitcnt vmcnt(" #n ")" ::: "memory")
#define PG8_WAIT_L(n) asm volatile("s_waitcnt lgkmcnt(" #n ")" ::: "memory")
#define PG8_BAR __builtin_amdgcn_s_barrier()
#define PG8_SCHED __builtin_amdgcn_sched_barrier(0)
    Unit cur, nxt; int ui = 0;
    if (!S.next(0, cur)) return;
    f32x4 acc[2][2][4][2];
#pragma unroll
    for (int a = 0; a < 2; ++a)
#pragma unroll
        for (int b = 0; b < 2; ++b)
#pragma unroll
            for (int m = 0; m < 4; ++m)
#pragma unroll
                for (int n = 0; n < 2; ++n) acc[a][b][m][n] = (f32x4){0.f, 0.f, 0.f, 0.f};
    bf16x8 At[4][2], B0[2][2], B1[2][2];
    unsigned gAc[2][2], gAn[2][2];
#define PG8_LOADROWS(u, dst) do { if constexpr (GATHER) { _Pragma("unroll") for (int h = 0; h < 2; ++h) _Pragma("unroll") for (int i = 0; i < 2; ++i) { int R, C; stage_rc(tid * 16 + i * 8192, R, C); \
        const int idx = h * HALF + R; const int e = (u).rows[idx < (u).mvalid ? idx : 0]; dst[h][i] = (unsigned)(e >> gshift) * lda + (unsigned)C * 2u; } } } while (0)
    PG8_LOADROWS(cur, gAc);
    unsigned cA = cur.A, cB = cur.B;
    S.a_ready(cur);
    PG8_STAGE_B(PG8_SB(0, 0), cB); PG8_STAGE_B(PG8_SB(0, 1), cB + hstepB); PG8_STAGE_A(PG8_SA(0, 0), cA, 0); PG8_STAGE_A(PG8_SA(0, 1), cA, 1);
    if (wr == 1) PG8_BAR;
    PG8_WAIT_V(2); PG8_BAR;
    PG8_STAGE_B(PG8_SB(1, 0), cB + kstep); PG8_STAGE_A(PG8_SA(1, 0), cA + kstep, 0); PG8_STAGE_B(PG8_SB(1, 1), cB + hstepB + kstep);
    PG8_WAIT_V(6); PG8_BAR;
    for (;;) {
        const bool has_next = S.next(ui + 1, nxt);
        if (has_next) { PG8_LOADROWS(nxt, gAn); } else if constexpr (GATHER) { _Pragma("unroll") for (int h = 0; h < 2; ++h) _Pragma("unroll") for (int i = 0; i < 2; ++i) gAn[h][i] = gAc[h][i]; }
        const unsigned nA = has_next ? nxt.A : cA, nB = has_next ? nxt.B : cB;
        for (int t = 0; t < nt; t += 2) {
            const bool last = (t == nt - 2);
            const unsigned a1 = cA + (unsigned)(t + 1) * kstep;
            const unsigned a2 = last ? nA : cA + (unsigned)(t + 2) * kstep, b2 = last ? nB : cB + (unsigned)(t + 2) * kstep;
            const unsigned a3 = a2 + kstep, b3 = b2 + kstep;
            if (last && has_next) S.a_ready(nxt);
            PG8_LDB(B0, 0, 0); PG8_LDB(B1, 0, 1); PG8_SCHED; PG8_LDA(At, 0, 0); PG8_STAGE_A(PG8_SA(1, 1), a1, 1);
            if constexpr (GATHER) { if (last) { _Pragma("unroll") for (int h = 0; h < 2; ++h) _Pragma("unroll") for (int i = 0; i < 2; ++i) gAc[h][i] = gAn[h][i]; } }
            PG8_WAIT_V(8); PG8_WAIT_L(0); PG8_BAR; PG8_MMA(0, 0, At, B0); PG8_MMA(0, 1, At, B1); PG8_BAR; PG8_SCHED;
            PG8_LDA(At, 0, 1); PG8_STAGE_B(PG8_SB(0, 0), b2); PG8_STAGE_B(PG8_SB(0, 1), b2 + hstepB); PG8_STAGE_A(PG8_SA(0, 0), a2, 0);
            PG8_WAIT_V(8); PG8_WAIT_L(0); PG8_BAR; PG8_MMA(1, 0, At, B0); PG8_MMA(1, 1, At, B1); PG8_BAR; PG8_SCHED;
            PG8_LDB(B0, 1, 0); PG8_LDB(B1, 1, 1); PG8_SCHED; PG8_LDA(At, 1, 0); PG8_STAGE_A(PG8_SA(0, 1), a2, 1);
            PG8_WAIT_V(8); PG8_WAIT_L(0); PG8_BAR; PG8_MMA(0, 0, At, B0); PG8_MMA(0, 1, At, B1); PG8_BAR; PG8_SCHED;
            PG8_LDA(At, 1, 1); PG8_STAGE_B(PG8_SB(1, 0), b3); PG8_STAGE_B(PG8_SB(1, 1), b3 + hstepB); PG8_STAGE_A(PG8_SA(1, 0), a3, 0);
            PG8_WAIT_V(8); PG8_WAIT_L(0); PG8_BAR; PG8_MMA(1, 0, At, B0); PG8_MMA(1, 1, At, B1); PG8_BAR; PG8_SCHED;
        }
        if constexpr (ALIGN_EPI) { if (wr == 0) PG8_BAR; }
        { int l_e; asm volatile("v_mbcnt_lo_u32_b32 %0, -1, 0\n\tv_mbcnt_hi_u32_b32 %0, -1, %0" : "=v"(l_e));
          E(acc, cur, wr, wc, l_e & 15, l_e >> 4); }
        S.done(cur);
        if (!(cur.flags & U_KEEP)) {
#pragma unroll
            for (int a = 0; a < 2; ++a)
#pragma unroll
                for (int b = 0; b < 2; ++b)
#pragma unroll
                    for (int m = 0; m < 4; ++m)
#pragma unroll
                        for (int n = 0; n < 2; ++n) acc[a][b][m][n] = (f32x4){0.f, 0.f, 0.f, 0.f};
        }
        if (!has_next) break;
        cur = nxt; cA = nA; cB = nB; ++ui;
        if constexpr (ALIGN_EPI) { if (wr == 1) PG8_BAR; }
    }
    PG8_WAIT_V(0);
    if constexpr (!ALIGN_EPI) { if (wr == 0) PG8_BAR; }
    PG8_BAR;
#undef PG8_SA
#undef PG8_SB
#undef PG8_STG
#undef PG8_STAGE_A
#undef PG8_STAGE_B
#undef PG8_LDA
#undef PG8_LDB
#undef PG8_MMA
#undef PG8_CAT
#undef PG8_WAIT_V
#undef PG8_WAIT_L
#undef PG8_BAR
#undef PG8_SCHED
#undef PG8_LOADROWS
}

typedef f32x4 Acc[2][2][4][2];
DEV u32x4 pack8(const f32x4 v0, const f32x4 v1) { u32x4 w; w.x = cvt_pk_bf16(v0[0], v0[1]); w.y = cvt_pk_bf16(v0[2], v0[3]); w.z = cvt_pk_bf16(v1[0], v1[1]); w.w = cvt_pk_bf16(v1[2], v1[3]); return w; }
DEV void unpack8(const u32x4 w, f32x4& v0, f32x4& v1) {
    v0[0] = __uint_as_float(w.x << 16); v0[1] = __uint_as_float(w.x & 0xffff0000u); v0[2] = __uint_as_float(w.y << 16); v0[3] = __uint_as_float(w.y & 0xffff0000u);
    v1[0] = __uint_as_float(w.z << 16); v1[1] = __uint_as_float(w.z & 0xffff0000u); v1[2] = __uint_as_float(w.w << 16); v1[3] = __uint_as_float(w.w & 0xffff0000u); }

struct EpiP1 {
    static constexpr bool PERM = true;
    bf16_t *AIN, *UU, *GV, *GATES; const float* bmg; float gsc;
    const float* rstd0;
    float* lns;
    DEV void operator()(Acc& acc, const Unit& u, int wr, int wc, int fr, int fq) const {
        const int pn = u.pn; int mode, ld, ct; bf16_t* base;
        if (pn < 4) { mode = 0; base = AIN; ld = 1024; ct = pn * 256; } else if (pn < 8) { mode = 1; base = UU; ld = 1024; ct = (pn - 4) * 256; }
        else if (pn < 12) { mode = 1; base = GV; ld = 1024; ct = (pn - 8) * 256; } else { mode = 2; base = GATES; ld = 4096; ct = (pn - 12) * 256; }
        const int row0 = u.pm * BM + wr * 64 + fr, col0 = ct + wc * 32 + 8 * fq;
        f32x4 bv[2][2];
#pragma unroll
        for (int bj = 0; bj < 2; ++bj)
#pragma unroll
            for (int n = 0; n < 2; ++n) bv[bj][n] = (mode == 2) ? *(const f32x4*)(bmg + col0 + bj * HALF + 4 * n) : (f32x4){0.f, 0.f, 0.f, 0.f};
        float rs[2][4];
#pragma unroll
        for (int ai = 0; ai < 2; ++ai)
#pragma unroll
            for (int m = 0; m < 4; ++m) rs[ai][m] = rstd0[row0 + ai * HALF + m * 16] * gsc;
#pragma unroll
        for (int ai = 0; ai < 2; ++ai)
#pragma unroll
            for (int m = 0; m < 4; ++m) { bf16_t* rowp = base + (size_t)(row0 + ai * HALF + m * 16) * ld + col0; float s1 = 0.f, s2 = 0.f;
#pragma unroll
                for (int bj = 0; bj < 2; ++bj) { f32x4 v0 = acc[ai][bj][m][0] * rs[ai][m] + bv[bj][0], v1 = acc[ai][bj][m][1] * rs[ai][m] + bv[bj][1];
                    if (mode == 1) {
#pragma unroll
                        for (int j = 0; j < 4; ++j) { v0[j] = gelu_t(v0[j]); v1[j] = gelu_t(v1[j]); } }
                    else if (mode == 2) {
#pragma unroll
                        for (int j = 0; j < 4; ++j) { v0[j] = sigm(v0[j]); v1[j] = sigm(v1[j]); } }
                    if (pn >= 8 && pn < 12) {
#pragma unroll
                        for (int j = 0; j < 4; ++j) { s1 += v0[j] + v1[j]; s2 += v0[j] * v0[j] + v1[j] * v1[j]; } }
                    *(u32x4*)(rowp + bj * HALF) = pack8(v0, v1); }
                if (pn >= 8 && pn < 12) {
                    s1 += __shfl_xor(s1, 16); s2 += __shfl_xor(s2, 16); s1 += __shfl_xor(s1, 32); s2 += __shfl_xor(s2, 32);
                    if (fq == 0) { f32x2 pr; pr.x = s1; pr.y = s2; *(f32x2*)(lns + ((size_t)(row0 + ai * HALF + m * 16) * 16 + (pn - 8) * 4 + wc) * 2) = pr; } } }
    }
};
struct EpiBf16S {
    static constexpr bool PERM = true;
    bf16_t* O; int ld; const float* scale;
    DEV void operator()(Acc& acc, const Unit& u, int wr, int wc, int fr, int fq) const {
        const int row0 = u.pm * BM + wr * 64 + fr, col0 = u.pn * BM + wc * 32 + 8 * fq;
#pragma unroll
        for (int bj = 0; bj < 2; ++bj) {
            f32x4 s0 = (f32x4){1.f, 1.f, 1.f, 1.f}, s1 = s0;
            if (scale) { s0 = *(const f32x4*)(scale + col0 + bj * HALF); s1 = *(const f32x4*)(scale + col0 + bj * HALF + 4); }
#pragma unroll
            for (int ai = 0; ai < 2; ++ai)
#pragma unroll
                for (int m = 0; m < 4; ++m) *(u32x4*)(O + (size_t)(row0 + ai * HALF + m * 16) * ld + col0 + bj * HALF) = pack8(acc[ai][bj][m][0] * s0, acc[ai][bj][m][1] * s1); }
    }
};
struct EpiMerge {
    static constexpr bool PERM = true;
    const bf16_t* GATES; bf16_t* MG;
    DEV void operator()(Acc& acc, const Unit& u, int wr, int wc, int fr, int fq) const {
        const int row0 = u.pm * BM + wr * 64 + fr, col0 = u.pn * BM + wc * 32 + 8 * fq;
        const bool first = (u.flags & U_KEEP) != 0;
#pragma unroll
        for (int ai = 0; ai < 2; ++ai) {
            u32x4 gb[4][2], ga[4][2];
#pragma unroll
            for (int m = 0; m < 4; ++m)
#pragma unroll
                for (int bj = 0; bj < 2; ++bj) { const size_t r = (size_t)(row0 + ai * HALF + m * 16); gb[m][bj] = *(const u32x4*)(GATES + r * 4096 + 2048 + col0 + bj * HALF);
                    if (first) ga[m][bj] = *(const u32x4*)(GATES + r * 4096 + col0 + bj * HALF); }
#pragma unroll
            for (int m = 0; m < 4; ++m)
#pragma unroll
                for (int bj = 0; bj < 2; ++bj) { const size_t r = (size_t)(row0 + ai * HALF + m * 16);
                    f32x4 b0, b1; unpack8(gb[m][bj], b0, b1);
                    if (first) { f32x4 a0, a1; unpack8(ga[m][bj], a0, a1);
#pragma unroll
                        for (int j = 0; j < 4; ++j) { acc[ai][bj][m][0][j] *= a0[j] * fast_rcp(b0[j]); acc[ai][bj][m][1][j] *= a1[j] * fast_rcp(b1[j]); } }
                    else *(u32x4*)(MG + r * 2048 + col0 + bj * HALF) = pack8(acc[ai][bj][m][0] * b0, acc[ai][bj][m][1] * b1); } }
    }
};
struct EpiResBf16 {
    static constexpr bool PERM = true;
    bf16_t* ob; unsigned char* oq;
    DEV void operator()(Acc& acc, const Unit& u, int wr, int wc, int fr, int fq) const {
        const int row0 = u.pm * BM + wr * 64 + fr, col0 = u.pn * BM + wc * 32 + 8 * fq;
#pragma unroll
        for (int ai = 0; ai < 2; ++ai) {
            u32x4 rv[4][2];
#pragma unroll
            for (int m = 0; m < 4; ++m)
#pragma unroll
                for (int bj = 0; bj < 2; ++bj) rv[m][bj] = *(const u32x4*)(ob + (size_t)(row0 + ai * HALF + m * 16) * 2048 + col0 + bj * HALF);
#pragma unroll
            for (int m = 0; m < 4; ++m)
#pragma unroll
                for (int bj = 0; bj < 2; ++bj) { const size_t off = (size_t)(row0 + ai * HALF + m * 16) * 2048 + col0 + bj * HALF; f32x4 r0, r1; unpack8(rv[m][bj], r0, r1);
                    const f32x4 v0 = r0 + acc[ai][bj][m][0], v1 = r1 + acc[ai][bj][m][1];
                    *(u32x4*)(ob + off) = pack8(v0, v1); u32x2 q; q.x = pk4_fp8(v0[0], v0[1], v0[2], v0[3]); q.y = pk4_fp8(v1[0], v1[1], v1[2], v1[3]); *(u32x2*)(oq + off) = q; } }
    }
};
struct EpiPleFinal {
    static constexpr bool PERM = true;
    const bf16_t* X2; const float* rstd; const float* bias; const bf16_t* PU; const float* gfin; float* out; float* ssq; unsigned* pcnt;
    DEV void operator()(Acc& acc, const Unit& u, int wr, int wc, int fr, int fq) const {
        const int row0 = u.pm * BM + wr * 64 + fr, col0 = u.pn * BM + wc * 32 + 8 * fq;
        int zdep = 0;
#pragma unroll
        for (int bj = 0; bj < 2; ++bj) {
            const f32x4 bv0 = *(const f32x4*)(bias + col0 + bj * HALF), bv1 = *(const f32x4*)(bias + col0 + bj * HALF + 4);
#pragma unroll
            for (int ai = 0; ai < 2; ++ai) {
                u32x4 xw[4], pw[4]; float rs[4];
#pragma unroll
                for (int m = 0; m < 4; ++m) { const size_t r = (size_t)(row0 + zdep + ai * HALF + m * 16); rs[m] = rstd[r] * (1.f / WGU_SCALE);
                    xw[m] = *(const u32x4*)(X2 + r * 2048 + col0 + bj * HALF); pw[m] = *(const u32x4*)(PU + r * 2048 + col0 + bj * HALF); }
#pragma unroll
                for (int m = 0; m < 4; ++m) { f32x4 x0, x1, p0, p1; unpack8(xw[m], x0, x1); unpack8(pw[m], p0, p1);
                    f32x4 g0 = acc[ai][bj][m][0] * rs[m] + bv0, g1 = acc[ai][bj][m][1] * rs[m] + bv1;
#pragma unroll
                    for (int q = 0; q < 4; ++q) { g0[q] = sigm(g0[q]); g1[q] = sigm(g1[q]); }
                    acc[ai][bj][m][0] = x0 + g0 * p0; acc[ai][bj][m][1] = x1 + g1 * p1; }
                asm volatile("" : "+v"(zdep), "+v"(acc[ai][bj][0][0]), "+v"(acc[ai][bj][1][0]), "+v"(acc[ai][bj][2][0]), "+v"(acc[ai][bj][3][0]), "+v"(acc[ai][bj][0][1]), "+v"(acc[ai][bj][1][1]), "+v"(acc[ai][bj][2][1]), "+v"(acc[ai][bj][3][1])); } }
        float sqv[2][4];
#pragma unroll
        for (int ai = 0; ai < 2; ++ai)
#pragma unroll
            for (int m = 0; m < 4; ++m) { float sq = 0.f;
#pragma unroll
                for (int bj = 0; bj < 2; ++bj)
#pragma unroll
                    for (int n = 0; n < 2; ++n) { const f32x4 v = acc[ai][bj][m][n]; sq += (v[0] * v[0] + v[1] * v[1]) + (v[2] * v[2] + v[3] * v[3]); }
                sq += __shfl_xor(sq, 16); sq += __shfl_xor(sq, 32); sqv[ai][m] = sq; }
        if (fq == 0) {
#pragma unroll
            for (int ai = 0; ai < 2; ++ai)
#pragma unroll
                for (int m = 0; m < 4; ++m) atomicAdd(ssq + row0 + ai * HALF + m * 16, sqv[ai][m]); }
        asm volatile("s_waitcnt vmcnt(0)" ::: "memory");
        unsigned* pc = pcnt + 64 * u.pm;
        if (fr == 0 && fq == 0) __hip_atomic_fetch_add(pc, 1u, __ATOMIC_RELAXED, __HIP_MEMORY_SCOPE_AGENT);
        { unsigned spins = 0; while ((unsigned)__builtin_amdgcn_readfirstlane((int)__hip_atomic_load(pc, __ATOMIC_RELAXED, __HIP_MEMORY_SCOPE_AGENT)) < 64u) { __builtin_amdgcn_s_sleep(2); if (++spins > (1u << 20)) break; } }
        float rsf[2][4];
#pragma unroll
        for (int ai = 0; ai < 2; ++ai)
#pragma unroll
            for (int m = 0; m < 4; ++m) rsf[ai][m] = rsqrtf(__hip_atomic_load(ssq + row0 + ai * HALF + m * 16, __ATOMIC_RELAXED, __HIP_MEMORY_SCOPE_AGENT) * (1.f / 2048.f) + 1e-6f);
#pragma unroll
        for (int bj = 0; bj < 2; ++bj) {
            const f32x4 g0 = *(const f32x4*)(gfin + col0 + bj * HALF), g1 = *(const f32x4*)(gfin + col0 + bj * HALF + 4);
#pragma unroll
            for (int ai = 0; ai < 2; ++ai)
#pragma unroll
                for (int m = 0; m < 4; ++m) { float* op = out + (size_t)(row0 + ai * HALF + m * 16) * 2048 + col0 + bj * HALF;
                    *(f32x4*)op = acc[ai][bj][m][0] * rsf[ai][m] * g0; *(f32x4*)(op + 4) = acc[ai][bj][m][1] * rsf[ai][m] * g1; } }
    }
};
struct EpiMoe1 {
    static constexpr bool PERM = true;
    unsigned char* HID; const float* rstd;
    DEV void operator()(Acc& acc, const Unit& u, int wr, int wc, int fr, int fq) const {
        const int col0 = u.pn * HALF + wc * 32 + 8 * fq;
        int aid[2][4];
#pragma unroll
        for (int ai = 0; ai < 2; ++ai)
#pragma unroll
            for (int m = 0; m < 4; ++m) { const int idx = ai * HALF + wr * 64 + m * 16 + fr; aid[ai][m] = u.rows[idx < u.mvalid ? idx : 0]; }
        float rsv[2][4];
#pragma unroll
        for (int ai = 0; ai < 2; ++ai)
#pragma unroll
            for (int m = 0; m < 4; ++m) rsv[ai][m] = rstd[aid[ai][m] >> 1];
#pragma unroll
        for (int ai = 0; ai < 2; ++ai)
#pragma unroll
            for (int m = 0; m < 4; ++m) { const int idx = ai * HALF + wr * 64 + m * 16 + fr;
                if (idx < u.mvalid) { f32x4 h0, h1; const float rs = rsv[ai][m] * (1.f / WGU_SCALE);
#pragma unroll
                    for (int j = 0; j < 4; ++j) { h0[j] = silu_f(rs * acc[ai][0][m][0][j]) * (rs * acc[ai][1][m][0][j]); h1[j] = silu_f(rs * acc[ai][0][m][1][j]) * (rs * acc[ai][1][m][1][j]); }
                    u32x2 q; q.x = pk4_fp8(clamp448(h0[0] * HID_SCALE), clamp448(h0[1] * HID_SCALE), clamp448(h0[2] * HID_SCALE), clamp448(h0[3] * HID_SCALE));
                    q.y = pk4_fp8(clamp448(h1[0] * HID_SCALE), clamp448(h1[1] * HID_SCALE), clamp448(h1[2] * HID_SCALE), clamp448(h1[3] * HID_SCALE));
                    __hip_atomic_store((unsigned long long*)(HID + (size_t)aid[ai][m] * 512 + col0), ((unsigned long long)q.y << 32) | q.x, __ATOMIC_RELAXED, __HIP_MEMORY_SCOPE_AGENT); } }
    }
};
struct EpiMoe2 {
    static constexpr bool PERM = true;
    unsigned char* Y; const float* ew;
    DEV void operator()(Acc& acc, const Unit& u, int wr, int wc, int fr, int fq) const {
        const int col0 = u.pn * BM + wc * 32 + 8 * fq;
        int aid[2][4]; float wv[2][4];
#pragma unroll
        for (int ai = 0; ai < 2; ++ai)
#pragma unroll
            for (int m = 0; m < 4; ++m) { const int idx = ai * HALF + wr * 64 + m * 16 + fr; aid[ai][m] = u.rows[idx < u.mvalid ? idx : 0]; }
#pragma unroll
        for (int ai = 0; ai < 2; ++ai)
#pragma unroll
            for (int m = 0; m < 4; ++m) wv[ai][m] = ew[aid[ai][m]] * (Y_SCALE / (HID_SCALE * WD_SCALE));
#pragma unroll
        for (int ai = 0; ai < 2; ++ai)
#pragma unroll
            for (int m = 0; m < 4; ++m) { const int idx = ai * HALF + wr * 64 + m * 16 + fr;
                if (idx < u.mvalid) {
#pragma unroll
                    for (int bj = 0; bj < 2; ++bj) { const f32x4 v0 = acc[ai][bj][m][0] * wv[ai][m], v1 = acc[ai][bj][m][1] * wv[ai][m];
                        u32x2 q; q.x = pk4_fp8(clamp448(v0[0]), clamp448(v0[1]), clamp448(v0[2]), clamp448(v0[3])); q.y = pk4_fp8(clamp448(v1[0]), clamp448(v1[1]), clamp448(v1[2]), clamp448(v1[3]));
                        *(u32x2*)(Y + (size_t)aid[ai][m] * 2048 + col0 + bj * HALF) = q; } } }
    }
};

struct SchedDense {
    unsigned lda, ldb; int nM, nN, G, c; int i0 = 0, iend = 1 << 30; int pn_off = 0;
    DEV bool next(int i, Unit& u) const { int pm, pn; if (i + i0 >= iend || !static_tile(i + i0, G, c, nM, nN, pm, pn)) return false;
        u.A = (unsigned)pm * BM * lda; u.B = (unsigned)pn * BM * ldb; u.rows = nullptr; u.pm = pm; u.pn = pn + pn_off; u.flags = 0; u.mvalid = BM; return true; }
    DEV void a_ready(const Unit&) const {} DEV void done(const Unit&) const {}
};
struct SchedDual {
    unsigned A1off, B1off; unsigned lda, ldb; int nM, nN, G, c;
    DEV bool next(int i, Unit& u) const { int pm, pn; if (!static_tile(i >> 1, G, c, nM, nN, pm, pn)) return false; const bool second = i & 1;
        u.A = (second ? A1off : 0u) + (unsigned)pm * BM * lda; u.B = (second ? B1off : 0u) + (unsigned)pn * BM * ldb; u.rows = nullptr; u.pm = pm; u.pn = pn; u.flags = second ? 0 : U_KEEP; u.mvalid = BM; return true; }
    DEV void a_ready(const Unit&) const {} DEV void done(const Unit&) const {}
};
struct SchedMoe {
    unsigned bestep; unsigned ldb; const int* list; const LAS int* pre; const LAS int* cl; int NT, G, c;
    unsigned* ready; int role, wave; int E = 0, SK = 0;
    DEV bool next(int i, Unit& u) const { const long L = (c < E) ? (long)SK * (G - E) + (long)i * G + c : (i < SK ? (long)i * (G - E) + (c - E) : (long)SK * (G - E) + (long)(i - SK) * G + c);
        const int total = __builtin_amdgcn_readfirstlane(pre[32]); if (L >= (long)total * NT) return false;
        const int rt = (int)(L / NT), pn = (int)(L % NT); int e = 0;
        for (int q = 1; q < 32; ++q) e += (pre[q] <= rt) ? 1 : 0;
        e = __builtin_amdgcn_readfirstlane(e);
        const int lt = rt - __builtin_amdgcn_readfirstlane(pre[e]); const int n = __builtin_amdgcn_readfirstlane(cl[e]);
        u.A = 0u; u.B = (unsigned)e * bestep + (unsigned)pn * BM * ldb; u.rows = list + e * CAP + lt * BM; u.pm = rt; u.pn = pn; u.flags = 0; u.mvalid = (n - lt * BM) < BM ? (n - lt * BM) : BM; return true; }
    DEV void a_ready(const Unit& u) const {
        if (role != 2) return;
        if (wave == 0) { unsigned* p = ready + 64 * u.pm; unsigned spins = 0;
            while ((unsigned)__builtin_amdgcn_readfirstlane((int)__hip_atomic_load(p, __ATOMIC_RELAXED, __HIP_MEMORY_SCOPE_AGENT)) < 32u) { __builtin_amdgcn_s_sleep(2); if (++spins > (1u << 20)) break; }
            __builtin_amdgcn_fence(__ATOMIC_ACQUIRE, "agent");
            asm volatile("s_waitcnt vmcnt(0)" ::: "memory"); }
        asm volatile("" ::: "memory"); __builtin_amdgcn_s_barrier(); asm volatile("" ::: "memory");
    }
    DEV void done(const Unit& u) const {
        if (role != 1) return;
        asm volatile("s_waitcnt vmcnt(0)" ::: "memory");
        if (__builtin_amdgcn_mbcnt_hi(~0u, __builtin_amdgcn_mbcnt_lo(~0u, 0u)) == 0u) __hip_atomic_fetch_add(ready + 64 * u.pm, 1u, __ATOMIC_RELAXED, __HIP_MEMORY_SCOPE_AGENT);
    }
};
struct SchedPanel {
    unsigned lda, ldb; int nM, G, v;
    DEV bool next(int i, Unit& u) const { const int pm = i * (G >> 3) + (v >> 3), pn = v & 7; if (pm >= nM) return false;
        u.A = (unsigned)pm * BM * lda; u.B = (unsigned)pn * BM * ldb; u.rows = nullptr; u.pm = pm; u.pn = pn; u.flags = 0; u.mvalid = BM; return true; }
    DEV void a_ready(const Unit&) const {} DEV void done(const Unit&) const {}
};
struct SchedOne { Unit u0; DEV bool next(int i, Unit& u) const { if (i != 0) return false; u = u0; return true; } DEV void a_ready(const Unit&) const {} DEV void done(const Unit&) const {} };
}

#define XB_TMO      128
#define XB_XCNT(j)  (256  + 64 * (j))
#define XB_XSUB(j)  (1280 + 64 * (j))
#define XB_XGEN(j)  (2304 + 64 * (j))
#define XB_TOP      3328
#define XB_TOPGEN   3392
#define XCD_BAR_WORDS 3456
#define XB_SPIN_CAP (1u << 18)
DEV unsigned xb_ld(unsigned* p)              { return __hip_atomic_load(p, __ATOMIC_RELAXED, __HIP_MEMORY_SCOPE_AGENT); }
DEV unsigned xb_add(unsigned* p, unsigned v) { return __hip_atomic_fetch_add(p, v, __ATOMIC_RELAXED, __HIP_MEMORY_SCOPE_AGENT); }
DEV unsigned xb_xcc_id() { return (unsigned)__builtin_amdgcn_s_getreg((3 << 11) | 20) & 0xFu; }
#define XB_SPIN(cond, bar) do { unsigned _sp = 0; while (cond) { __builtin_amdgcn_s_sleep(1); \
    if ((++_sp & 255u) == 0u) { if (xb_ld(&(bar)[XB_TMO])) break; if (_sp > XB_SPIN_CAP) { atomicAdd(&(bar)[XB_TMO], 1u); break; } } } } while (0)
struct XcdBarrier { unsigned* bar; unsigned x; volatile LAS unsigned* st; };
DEV XcdBarrier xcd_barrier_post(unsigned* bar, volatile LAS unsigned* st) {
    XcdBarrier b; b.bar = bar; b.x = xb_xcc_id(); b.st = st;
    if (threadIdx.x == 0) (void)xb_add(&bar[XB_XCNT(b.x)], 1u);
    return b;
}
DEV void xcd_barrier_complete(unsigned* bar, unsigned x, unsigned& nloc, unsigned& nx) {
    const unsigned G = gridDim.x * gridDim.y * gridDim.z;
    unsigned sum, cnt, mine, sp = 0u;
    for (;;) {
        sum = 0u; cnt = 0u; mine = 0u;
#pragma unroll
        for (unsigned j = 0; j < 16; ++j) { const unsigned c = xb_ld(&bar[XB_XCNT(j)]); sum += c; cnt += (c > 0u) ? 1u : 0u; mine = (j == x) ? c : mine; }
        if (sum == G) break;
        __builtin_amdgcn_s_sleep(1);
        if ((++sp & 255u) == 0u) { if (xb_ld(&bar[XB_TMO])) break; if (sp > XB_SPIN_CAP) { atomicAdd(&bar[XB_TMO], 1u); break; } }
    }
    nloc = mine > 0u ? mine : 1u; nx = cnt > 0u ? cnt : 1u;
}
DEV void xcd_barrier(const XcdBarrier& b, const int wave_s) {
    asm volatile("s_waitcnt vmcnt(0)" ::: "memory");
    __syncthreads();
    if (wave_s == 0 && __builtin_amdgcn_mbcnt_hi(~0u, __builtin_amdgcn_mbcnt_lo(~0u, 0u)) == 0u) {
        unsigned* bar = b.bar;
        __builtin_amdgcn_s_waitcnt(0);
        unsigned nloc = b.st[0], nx = b.st[1];
        if (nloc == 0u) { xcd_barrier_complete(bar, b.x, nloc, nx); b.st[0] = nloc; b.st[1] = nx; }
        const unsigned old = xb_add(&bar[XB_XSUB(b.x)], 1u);
        const unsigned gen = old / nloc;
        if (old + 1u == (gen + 1u) * nloc) {
            __builtin_amdgcn_fence(__ATOMIC_RELEASE, "agent");
            asm volatile("s_waitcnt vmcnt(0)" ::: "memory");
            const unsigned og = xb_add(&bar[XB_TOP], 1u);
            const unsigned tg = og / nx;
            if (og + 1u == (tg + 1u) * nx) xb_add(&bar[XB_TOPGEN], 1u);
            else XB_SPIN(xb_ld(&bar[XB_TOPGEN]) == tg, bar);
            __builtin_amdgcn_fence(__ATOMIC_ACQUIRE, "agent");
            xb_add(&bar[XB_XGEN(b.x)], 1u);
            asm volatile("s_waitcnt vmcnt(0)" ::: "memory");
        } else {
            XB_SPIN(xb_ld(&bar[XB_XGEN(b.x)]) == gen, bar);
            __builtin_amdgcn_fence(__ATOMIC_ACQUIRE, "agent");
            asm volatile("s_waitcnt vmcnt(0)" ::: "memory");
        }
    }
    __syncthreads();
}


#define LDS_WAIT() asm volatile("s_waitcnt lgkmcnt(0)" ::: "memory")
#define VM_WAIT() asm volatile("s_waitcnt vmcnt(0)" ::: "memory")
DEV float wave_sum(float v) {
#pragma unroll
    for (int o = 1; o < 64; o <<= 1) v += __shfl_xor(v, o);
    return v;
}
DEV unsigned pk2(float lo, float hi) { return pg8::cvt_pk_bf16(lo, hi); }
struct ItemD { const float* src; unsigned char* dst; const float* ks; int N, K; float cs; int q8; };
DEV bool item_try(int& r, ItemD& d, const float* W, int K, int N, int batch, long sstride, long dstride, void* WT, int mode, int row_off, const float* kscale, float cs, int q8, int ld = 0) {
    const int ik = q8 ? 128 : 64, in = q8 ? 32 : 64;
    const int nnb = N / in, per = (K / ik) * nnb, tot = per * batch;
    if (r >= tot) { r -= tot; return false; }
    const int b = r / per, q = r % per, k0 = (q / nnb) * ik, n0 = (q % nnb) * in;
    const int drow0 = mode == 0 ? row_off + n0 : 256 * (n0 >> 7) + (n0 & 127) + (mode == 2 ? 128 : 0);
    const int ldn = ld ? ld : N;
    d.src = W + (size_t)b * sstride + (size_t)k0 * ldn + n0; d.N = ldn; d.K = K; d.cs = cs; d.q8 = q8; d.ks = kscale ? kscale + k0 : nullptr;
    d.dst = (unsigned char*)WT + ((size_t)b * dstride + (size_t)drow0 * K + k0) * (q8 ? 1 : 2);
    return true;
}
DEV void item_load(const ItemD& d, f32x4 (&v)[16], f32x4 (&sc)[4], int lane) {
    const int kk = d.q8 ? lane >> 3 : lane >> 4, nq = d.q8 ? lane & 7 : lane & 15;
#pragma unroll
    for (int t = 0; t < 4; ++t) sc[t] = d.ks ? *(const f32x4*)(d.ks + 16 * kk + 4 * t) : (f32x4){1.f, 1.f, 1.f, 1.f};
    const float* p = d.src + (size_t)(16 * kk) * d.N + 4 * nq;
#pragma unroll
    for (int i = 0; i < 16; ++i) v[i] = *(const f32x4*)(p + (size_t)i * d.N);
}
DEV void item_finish(const ItemD& d, const f32x4 (&v)[16], const f32x4 (&sc)[4], int lane) {
    const int kk = d.q8 ? lane >> 3 : lane >> 4, nq = d.q8 ? lane & 7 : lane & 15; const float cs = d.cs;
#pragma unroll
    for (int c = 0; c < 4; ++c) {
        float e[16];
#pragma unroll
        for (int i = 0; i < 16; ++i) e[i] = v[i][c] * (sc[i >> 2][i & 3] * cs);
        if (d.q8) { u32x4 o; o.x = pg8::pk4_fp8(e[0], e[1], e[2], e[3]); o.y = pg8::pk4_fp8(e[4], e[5], e[6], e[7]); o.z = pg8::pk4_fp8(e[8], e[9], e[10], e[11]); o.w = pg8::pk4_fp8(e[12], e[13], e[14], e[15]);
            *(u32x4*)(d.dst + (size_t)(4 * nq + c) * d.K + 16 * kk) = o; }
        else { u32x4 o0, o1; o0.x = pk2(e[0], e[1]); o0.y = pk2(e[2], e[3]); o0.z = pk2(e[4], e[5]); o0.w = pk2(e[6], e[7]); o1.x = pk2(e[8], e[9]); o1.y = pk2(e[10], e[11]); o1.z = pk2(e[12], e[13]); o1.w = pk2(e[14], e[15]);
            unsigned char* p = d.dst + ((size_t)(4 * nq + c) * d.K + 16 * kk) * 2; *(u32x4*)p = o0; *(u32x4*)(p + 16) = o1; } }
}
#define ITEM_STREAM(DEC, first, stride, count, lane) do { \
    ItemD dc_, dn_; f32x4 vc_[16], vn_[16], sc_[4], sn_[4]; int it_ = (first); \
    if (it_ < (count)) { DEC(it_, dc_); item_load(dc_, vc_, sc_, lane); \
        for (;;) { const int itn_ = it_ + (stride); const bool hn_ = itn_ < (count); \
            if (hn_) { DEC(itn_, dn_); item_load(dn_, vn_, sn_, lane); } \
            item_finish(dc_, vc_, sc_, lane); \
            if (!hn_) break; \
            dc_ = dn_; _Pragma("unroll") for (int q_ = 0; q_ < 16; ++q_) vc_[q_] = vn_[q_]; _Pragma("unroll") for (int q_ = 0; q_ < 4; ++q_) sc_[q_] = sn_[q_]; it_ = itn_; } } } while (0)
DEV void rms_row_q(const float* xrow, bf16_t* orow, unsigned char* oq, float* rstd_out, int lane) {
    f32x4 v[8]; float s = 0.f;
#pragma unroll
    for (int q = 0; q < 8; ++q) v[q] = *((const f32x4*)xrow + lane + 64 * q);
#pragma unroll
    for (int q = 0; q < 8; ++q) { s += (v[q][0] * v[q][0] + v[q][1] * v[q][1]) + (v[q][2] * v[q][2] + v[q][3] * v[q][3]);
        u32x2 o; o.x = pk2(v[q][0], v[q][1]); o.y = pk2(v[q][2], v[q][3]); *((u32x2*)orow + lane + 64 * q) = o;
        *((unsigned*)oq + lane + 64 * q) = pg8::pk4_fp8(v[q][0], v[q][1], v[q][2], v[q][3]); }
    s = wave_sum(s);
    if (lane == 0) *rstd_out = rsqrtf(s * (1.f / D) + EPS);
}
DEV void x2_row(const bf16_t* xrow, const unsigned char* y0, const unsigned char* y1, bf16_t* orow, unsigned char* oq, float* rstd_out, int lane) {
    u32x4 a[4]; u32x2 b[4], c[4];
#pragma unroll
    for (int j = 0; j < 4; ++j) { a[j] = *((const u32x4*)xrow + lane + 64 * j); b[j] = *((const u32x2*)y0 + lane + 64 * j); c[j] = *((const u32x2*)y1 + lane + 64 * j); }
    float s = 0.f;
#pragma unroll
    for (int j = 0; j < 4; ++j) { f32x4 v0, v1; pg8::unpack8(a[j], v0, v1);
        const f32x2 b0 = __builtin_amdgcn_cvt_pk_f32_fp8((int)b[j].x, false), b1 = __builtin_amdgcn_cvt_pk_f32_fp8((int)b[j].x, true), b2 = __builtin_amdgcn_cvt_pk_f32_fp8((int)b[j].y, false), b3 = __builtin_amdgcn_cvt_pk_f32_fp8((int)b[j].y, true);
        const f32x2 c0 = __builtin_amdgcn_cvt_pk_f32_fp8((int)c[j].x, false), c1 = __builtin_amdgcn_cvt_pk_f32_fp8((int)c[j].x, true), c2 = __builtin_amdgcn_cvt_pk_f32_fp8((int)c[j].y, false), c3 = __builtin_amdgcn_cvt_pk_f32_fp8((int)c[j].y, true);
        const float is = 1.f / Y_SCALE;
        v0[0] += (b0.x + c0.x) * is; v0[1] += (b0.y + c0.y) * is; v0[2] += (b1.x + c1.x) * is; v0[3] += (b1.y + c1.y) * is;
        v1[0] += (b2.x + c2.x) * is; v1[1] += (b2.y + c2.y) * is; v1[2] += (b3.x + c3.x) * is; v1[3] += (b3.y + c3.y) * is;
        s += ((v0[0] * v0[0] + v0[1] * v0[1]) + (v0[2] * v0[2] + v0[3] * v0[3])) + ((v1[0] * v1[0] + v1[1] * v1[1]) + (v1[2] * v1[2] + v1[3] * v1[3]));
        *((u32x4*)orow + lane + 64 * j) = pg8::pack8(v0, v1);
        u32x2 q; q.x = pg8::pk4_fp8(v0[0], v0[1], v0[2], v0[3]); q.y = pg8::pk4_fp8(v1[0], v1[1], v1[2], v1[3]); *((u32x2*)oq + lane + 64 * j) = q; }
    s = wave_sum(s);
    if (lane == 0) *rstd_out = rsqrtf(s * (1.f / D) + EPS);
}
DEV void zp_block(const bf16_t* AIN, bf16_t* ZP, int pm, int g, int tid) {
    const int c8 = tid & 31, run = tid >> 5, w = 2 << g;
    const int R0 = pm * 256 + run * 16, seq0 = R0 & ~(SEQ - 1), col = g * 256 + c8 * 8;
    u32x4 raw[31];
#pragma unroll
    for (int i = 0; i < 31; ++i) { const int R = R0 - 15 + i; raw[i] = *(const u32x4*)(AIN + (size_t)(R >= seq0 ? R : R0) * PW + col); }
    f32x4 s0 = (f32x4){0.f, 0.f, 0.f, 0.f}, s1 = s0;
#pragma unroll
    for (int i = 0; i < 15; ++i) { const int R = R0 - 15 + i; f32x4 a0, a1; pg8::unpack8(raw[i], a0, a1); const bool in = (15 - i) < w && R >= seq0; if (in) { s0 += a0; s1 += a1; } }
#pragma unroll
    for (int i = 0; i < 16; ++i) { const int R = R0 + i; f32x4 a0, a1; pg8::unpack8(raw[15 + i], a0, a1);
        s0 += a0; s1 += a1;
        const int tt = R - seq0; const float inv = 1.f / (float)((tt + 1 < w) ? tt + 1 : w);
        *(u32x4*)(ZP + (size_t)R * PW + col) = pg8::pack8(s0 * inv - a0, s1 * inv - a1);
        f32x4 b0, b1;
        if (w == 2) pg8::unpack8(raw[15 + i - 1], b0, b1); else if (w == 4) pg8::unpack8(raw[15 + i - 3], b0, b1); else if (w == 8) pg8::unpack8(raw[15 + i - 7], b0, b1); else pg8::unpack8(raw[i], b0, b1);
        if (R - w + 1 >= seq0) { s0 -= b0; s1 -= b1; } }
}
constexpr int VT_STRIDE = 272;
DEV void sgu_unit(LAS unsigned char* lds, const float* LNS, const bf16_t* GV, const bf16_t* UU, const bf16_t* WSb, const float* bsp, const float* lg, const float* lb, bf16_t* SB, int nb, int hf, int tid) {
    const int lane = tid & 63, wave = __builtin_amdgcn_readfirstlane(tid >> 6), fr = lane & 15, fq = lane >> 4;
    LAS float* st = (LAS float*)lds;
    LAS unsigned char* vt = lds + 2048;
    const int t0 = nb * 128;
    if (tid < 128) { float s1 = 0.f, s2 = 0.f; const f32x4* lp = (const f32x4*)(LNS + (size_t)(t0 + tid) * 32);
#pragma unroll
        for (int k = 0; k < 8; ++k) { const f32x4 q = lp[k]; s1 += q[0]; s2 += q[1]; s1 += q[2]; s2 += q[3]; }
        const float mean = s1 * (1.f / SW), var = __builtin_fmaxf(s2 * (1.f / SW) - mean * mean, 0.f);
        st[2 * tid] = mean; st[2 * tid + 1] = rsqrtf(var + EPS); }
    __syncthreads();
    const int half = wave >> 2, wv = wave & 3, th = tid & 255;
    LAS unsigned char* vb = vt + half * (128 * VT_STRIDE);
    for (int rd = 0; rd < 2; ++rd) { const int g = hf * 4 + rd * 2 + half;
        const int s4 = th & 31, c8a = th >> 5;
        f32x4 lgv[2][2], lbv[2][2]; u32x4 gvr[2][4];
#pragma unroll
        for (int h = 0; h < 2; ++h) { const int cg = g * 128 + (c8a + 8 * h) * 8; lgv[h][0] = *(const f32x4*)(lg + cg); lgv[h][1] = *(const f32x4*)(lg + cg + 4); lbv[h][0] = *(const f32x4*)(lb + cg); lbv[h][1] = *(const f32x4*)(lb + cg + 4); }
#pragma unroll
        for (int h = 0; h < 2; ++h)
#pragma unroll
            for (int i = 0; i < 4; ++i) gvr[h][i] = *(const u32x4*)(GV + (size_t)(t0 + 4 * s4 + i) * SW + g * 128 + (c8a + 8 * h) * 8);
        bf16x8 wf[2][4]; u32x2 uws[2][8]; float bias[2];
#pragma unroll
        for (int tb = 0; tb < 2; ++tb)
#pragma unroll
            for (int kk = 0; kk < 4; ++kk) wf[tb][kk] = *(const bf16x8*)(WSb + (size_t)(g * 128 + (wv + 4 * tb) * 16 + fr) * 128 + kk * 32 + fq * 8);
#pragma unroll
        for (int tb = 0; tb < 2; ++tb) { bias[tb] = bsp[g * 128 + (wv + 4 * tb) * 16 + fr];
#pragma unroll
            for (int cb = 0; cb < 8; ++cb) uws[tb][cb] = *(const u32x2*)(UU + (size_t)(t0 + (wv + 4 * tb) * 16 + fr) * SW + g * 128 + cb * 16 + fq * 4); }
        if (rd) __syncthreads();
#pragma unroll
        for (int h = 0; h < 2; ++h) { const int c8 = c8a + 8 * h; f32x4 v0[4], v1[4];
#pragma unroll
            for (int i = 0; i < 4; ++i) { const int r = 4 * s4 + i; pg8::unpack8(gvr[h][i], v0[i], v1[i]);
                const float mean = st[2 * r], rstd = st[2 * r + 1]; v0[i] = (v0[i] - mean) * rstd * lgv[h][0] + lbv[h][0]; v1[i] = (v1[i] - mean) * rstd * lgv[h][1] + lbv[h][1]; }
#pragma unroll
            for (int q = 0; q < 4; ++q) { u32x2 o; o.x = pk2(v0[0][q], v0[1][q]); o.y = pk2(v0[2][q], v0[3][q]); *(LAS u32x2*)(vb + (c8 * 8 + q) * VT_STRIDE + s4 * 8) = o;
                u32x2 o2; o2.x = pk2(v1[0][q], v1[1][q]); o2.y = pk2(v1[2][q], v1[3][q]); *(LAS u32x2*)(vb + (c8 * 8 + 4 + q) * VT_STRIDE + s4 * 8) = o2; } }
        __syncthreads();
        f32x4 acc[2][8];
#pragma unroll
        for (int tb = 0; tb < 2; ++tb)
#pragma unroll
            for (int cb = 0; cb < 8; ++cb) acc[tb][cb] = (f32x4){0.f, 0.f, 0.f, 0.f};
#pragma unroll
        for (int cb = 0; cb < 8; ++cb)
#pragma unroll
            for (int kk = 0; kk < 4; ++kk) { const bf16x8 af = *(const LAS bf16x8*)(vb + (cb * 16 + fr) * VT_STRIDE + (kk * 32 + fq * 8) * 2);
                acc[0][cb] = __builtin_amdgcn_mfma_f32_16x16x32_bf16(af, wf[0][kk], acc[0][cb], 0, 0, 0);
                acc[1][cb] = __builtin_amdgcn_mfma_f32_16x16x32_bf16(af, wf[1][kk], acc[1][cb], 0, 0, 0); }
#pragma unroll
        for (int tb = 0; tb < 2; ++tb) { const int tg = t0 + (wv + 4 * tb) * 16 + fr;
#pragma unroll
            for (int cb = 0; cb < 8; ++cb) { const size_t off = (size_t)tg * SW + g * 128 + cb * 16 + fq * 4; const u32x2 uw = uws[tb][cb];
                u32x2 o; o.x = pk2(__uint_as_float(uw.x << 16) * (acc[tb][cb][0] + bias[tb]), __uint_as_float(uw.x & 0xffff0000u) * (acc[tb][cb][1] + bias[tb]));
                o.y = pk2(__uint_as_float(uw.y << 16) * (acc[tb][cb][2] + bias[tb]), __uint_as_float(uw.y & 0xffff0000u) * (acc[tb][cb][3] + bias[tb]));
                *(u32x2*)(SB + off) = o; } }
    }
    __syncthreads();
}

constexpr int RP_STRIDE = 52;
DEV void split8(const f32x4 a0, const f32x4 a1, bf16x8& hi, bf16x8& lo) {
    u32x4 h; h.x = pk2(a0[0], a0[1]); h.y = pk2(a0[2], a0[3]); h.z = pk2(a1[0], a1[1]); h.w = pk2(a1[2], a1[3]);
    f32x4 r0, r1; pg8::unpack8(h, r0, r1); r0 = a0 - r0; r1 = a1 - r1;
    u32x4 l; l.x = pk2(r0[0], r0[1]); l.y = pk2(r0[2], r0[3]); l.z = pk2(r1[0], r1[1]); l.w = pk2(r1[2], r1[3]);
    hi = __builtin_bit_cast(bf16x8, h); lo = __builtin_bit_cast(bf16x8, l);
}
DEV void router_group(LAS unsigned char* lds, const bf16_t* x1, const bf16_t* WRh, const bf16_t* WRl, const float* b_rg, const float* b_re,
                      float* ew, float* rstd_out, int* cnt, int* list, int grp, int tid) {
    const int lane = tid & 63, wave = __builtin_amdgcn_readfirstlane(tid >> 6), fr = lane & 15, fq = lane >> 4;
    LAS float* part = (LAS float*)lds;
    LAS float* ssb = (LAS float*)(lds + 8 * 64 * RP_STRIDE * 4);
    LAS int* hist = (LAS int*)(lds + 8 * 64 * RP_STRIDE * 4 + 2048);
    LAS int* base = hist + 32;
    const int row0 = grp * 64;
    if (tid < 32) hist[tid] = 0;
    f32x4 acc[4][3]; float ssp[4];
#pragma unroll
    for (int rb = 0; rb < 4; ++rb) { ssp[rb] = 0.f;
#pragma unroll
        for (int nb = 0; nb < 3; ++nb) acc[rb][nb] = (f32x4){0.f, 0.f, 0.f, 0.f}; }
#pragma unroll 4
    for (int ks = 0; ks < 8; ++ks) { const int k0 = wave * 256 + ks * 32 + fq * 8;
        bf16x8 bh[3], bl[3];
#pragma unroll
        for (int nb = 0; nb < 3; ++nb) { bh[nb] = *(const bf16x8*)(WRh + (size_t)(nb * 16 + fr) * D + k0); bl[nb] = *(const bf16x8*)(WRl + (size_t)(nb * 16 + fr) * D + k0); }
        u32x4 xa[4];
#pragma unroll
        for (int rb = 0; rb < 4; ++rb) xa[rb] = *(const u32x4*)(x1 + (size_t)(row0 + rb * 16 + fr) * D + k0);
#pragma unroll
        for (int rb = 0; rb < 4; ++rb) { f32x4 a0, a1; pg8::unpack8(xa[rb], a0, a1);
            ssp[rb] += ((a0[0] * a0[0] + a0[1] * a0[1]) + (a0[2] * a0[2] + a0[3] * a0[3])) + ((a1[0] * a1[0] + a1[1] * a1[1]) + (a1[2] * a1[2] + a1[3] * a1[3]));
            const bf16x8 ah = __builtin_bit_cast(bf16x8, xa[rb]);
#pragma unroll
            for (int nb = 0; nb < 3; ++nb) { acc[rb][nb] = __builtin_amdgcn_mfma_f32_16x16x32_bf16(ah, bh[nb], acc[rb][nb], 0, 0, 0);
                acc[rb][nb] = __builtin_amdgcn_mfma_f32_16x16x32_bf16(ah, bl[nb], acc[rb][nb], 0, 0, 0); } }
    }
    LAS float* pw = part + wave * 64 * RP_STRIDE;
#pragma unroll
    for (int rb = 0; rb < 4; ++rb) { float v = ssp[rb]; v += __shfl_xor(v, 16); v += __shfl_xor(v, 32); if (fq == 0) ssb[wave * 64 + rb * 16 + fr] = v;
#pragma unroll
        for (int nb = 0; nb < 3; ++nb)
#pragma unroll
            for (int q = 0; q < 4; ++q) pw[(rb * 16 + 4 * fq + q) * RP_STRIDE + nb * 16 + fr] = acc[rb][nb][q]; }
    __syncthreads();
    int e0 = 0, e1 = 0, lr0 = 0, lr1 = 0; float w0 = 0.f, w1 = 0.f;
    if (tid < 64) { const int r = tid;
        float ss = 0.f;
#pragma unroll
        for (int w = 0; w < 8; ++w) ss += ssb[w * 64 + r];
        const float rstd = rsqrtf(ss * (1.f / D) + EPS);
        rstd_out[row0 + r] = rstd;
        float gl[4];
#pragma unroll
        for (int o = 0; o < 4; ++o) { float sacc = 0.f;
#pragma unroll
            for (int w = 0; w < 8; ++w) sacc += part[(w * 64 + r) * RP_STRIDE + o];
            gl[o] = sacc * rstd + b_rg[o]; }
        float best = gl[0]; int gi = 0;
#pragma unroll
        for (int o = 1; o < 4; ++o) if (gl[o] > best) { best = gl[o]; gi = o; }
        float se = 0.f;
#pragma unroll
        for (int o = 0; o < 4; ++o) se += __expf(gl[o] - best);
        const float gp = 1.f / se;
        float l0 = -3.0e38f, l1 = -3.0e38f; int i0 = 0, i1 = 0;
        for (int o = 0; o < 8; ++o) { float sacc = 0.f;
#pragma unroll
            for (int w = 0; w < 8; ++w) sacc += part[(w * 64 + r) * RP_STRIDE + 4 + gi * 8 + o];
            const float sv = sacc * rstd + b_re[gi * 8 + o];
            if (sv > l0) { l1 = l0; i1 = i0; l0 = sv; i0 = o; } else if (sv > l1) { l1 = sv; i1 = o; } }
        const float e = __expf(l1 - l0);
        w0 = gp / (1.f + e); w1 = gp * e / (1.f + e); e0 = gi * 8 + i0; e1 = gi * 8 + i1;
        lr0 = atomicAdd((int*)(hist + e0), 1); lr1 = atomicAdd((int*)(hist + e1), 1);
    }
    __syncthreads();
    if (tid < 32) { const int n = hist[tid]; base[tid] = n ? atomicAdd(cnt + tid, n) : 0; }
    __syncthreads();
    if (tid < 64) { const int t = row0 + tid; ew[2 * t] = w0; ew[2 * t + 1] = w1;
        list[e0 * CAP + base[e0] + lr0] = 2 * t; list[e1 * CAP + base[e1] + lr1] = 2 * t + 1; }
    __syncthreads();
}

constexpr int NWAVES = 8;
constexpr int RING_OFF = 0, RING_BYTES = 131072;
constexpr int LDSCTL_OFF = RING_BYTES, MISC_OFF = LDSCTL_OFF + 320;
constexpr int LDS_BYTES = 147456;
constexpr int CW_BAR = 4096;
constexpr size_t WS_PU = 550 * MiB;
constexpr size_t WS_END2 = 614 * MiB;
constexpr int N_PHASES = 10;

struct Args { const float* in[28]; float* out; unsigned char* ws; int ph_lo, ph_hi, li, pad; };

DEV void moe_tables(LAS int* pre, LAS int* cl, const int* cnt, int tid) {
    if (tid == 0) { int a = 0; for (int e = 0; e < 32; ++e) { const int n = cnt[e]; cl[e] = n; pre[e] = a; a += (n + 255) >> 8; } pre[32] = a; }
    __syncthreads();
}

__global__ void __launch_bounds__(NWAVES * 64, 2) mk_fwd(Args args) {
    extern __shared__ __attribute__((aligned(16))) unsigned char lds_raw[];
    LAS unsigned char* lds = (LAS unsigned char*)lds_raw;
    volatile LAS unsigned* MISC = (volatile LAS unsigned*)(lds + MISC_OFF);
    const int G = gridDim.x; const int bx = blockIdx.x;
    const int wave_s = __builtin_amdgcn_readfirstlane(threadIdx.x >> 6);
    for (int u = threadIdx.x; u < (LDS_BYTES - LDSCTL_OFF) / 4; u += NWAVES * 64) ((LAS unsigned*)(lds + LDSCTL_OFF))[u] = 0u;
    __syncthreads();
    const int lo = args.ph_lo, hi = args.ph_hi;
    XcdBarrier bar; bar.bar = (unsigned*)(args.ws + WS_CTL) + CW_BAR + args.li * XCD_BAR_WORDS; bar.x = 0; bar.st = nullptr;
    if (hi - lo > 1) bar = xcd_barrier_post((unsigned*)(args.ws + WS_CTL) + CW_BAR + args.li * XCD_BAR_WORDS, MISC + 8);
#ifndef PH_EN
#define PH_EN 0x3FF
#endif
#ifndef REPEAT_PH
#define REPEAT_PH -1
#endif
#define IN(k) (((PH_EN >> (k)) & 1) && lo <= (k) && (k) < hi)
#ifndef SEAM_REPS
#define SEAM_REPS 1
#endif
#define SEAM(k) do { if (IN(k) && IN((k) + 1)) { for (int sr_ = 0; sr_ < SEAM_REPS; ++sr_) xcd_barrier(bar, wave_s); } } while (0)
#define REPS(k) (((k) == REPEAT_PH) ? 2 : 1)
#define PHASE_BEGIN \
    int tid; asm volatile("v_mbcnt_lo_u32_b32 %0, -1, 0\n\tv_mbcnt_hi_u32_b32 %0, -1, %0" : "=v"(tid)); tid += wave_s * 64; \
    const __attribute__((address_space(4))) Args* ap = (const __attribute__((address_space(4))) Args*)__builtin_amdgcn_kernarg_segment_ptr(); asm volatile("" : "+s"(ap)); \
    unsigned char* ws = ap->ws; float* out = ap->out; \
    const int lane = tid & 63, wave = __builtin_amdgcn_readfirstlane(tid >> 6); \
    const int vcu = (G % 8 == 0) ? (bx % 8) * (G / 8) + bx / 8 : bx; const int gw = vcu * NWAVES + wave, NGW = G * NWAVES; \
    (void)lane; (void)wave; (void)gw; (void)NGW; (void)ws; (void)out;
#define WSP(T_, off) ((T_*)(ws + (off)))
    LAS int* pre = (LAS int*)(lds + LDSCTL_OFF + 1024); LAS int* cl = pre + 64;

    for (int rep_ = 0; rep_ < REPS(0); ++rep_) { if (rep_) xcd_barrier(bar, wave_s);
    if (IN(0)) { PHASE_BEGIN
        bf16_t* W1t = WSP(bf16_t, WS_W1T);
        constexpr int NITEMS = (D / 64) * (NIN / 64) + (D / 64) * (2 * D / 64) + 2 * (PW / 64) * (D / 64) + 2 * (D / 64) * (D / 64) + (PLE / 64) * (D / 64);
#define DEC_P0(r_in, d) do { int r = (r_in); \
            if (item_try(r, d, ap->in[3], D, PW, 1, 0, 0, W1t, 0, 0, ap->in[2], 1.f, 0, NIN)) break;     \
            if (item_try(r, d, ap->in[3] + PW, D, 2 * SW, 1, 0, 0, WSP(bf16_t, WS_WMGQ), 0, 0, ap->in[2], WGU_SCALE, 1, NIN)) break;     \
            if (item_try(r, d, ap->in[12], D, 2 * D, 1, 0, 0, WSP(bf16_t, WS_WMGQ), 0, 2 * SW, ap->in[2], WGU_SCALE, 1)) break;     \
            if (item_try(r, d, ap->in[6], PW, D, 1, 0, 0, WSP(bf16_t, WS_WAT), 0, 0, nullptr, 1.f, 0)) break; \
            if (item_try(r, d, ap->in[11], SW, D, 1, 0, 0, WSP(bf16_t, WS_WBT), 0, 0, nullptr, 1.f, 0)) break; \
            if (item_try(r, d, ap->in[14], D, D, 1, 0, 0, WSP(bf16_t, WS_WOT), 0, 0, nullptr, 1.f, 0)) break; \
            if (item_try(r, d, ap->in[24], D, D, 1, 0, 0, WSP(bf16_t, WS_WPGT), 0, 0, ap->in[23], WGU_SCALE, 1)) break;     \
            item_try(r, d, ap->in[26], PLE, D, 1, 0, 0, WSP(bf16_t, WS_WPUT), 0, 0, nullptr, 1.f, 0); } while (0)
        { const int ch = (NITEMS + NGW - 1) / NGW, lo_ = gw * ch, hi_ = (lo_ + ch) < NITEMS ? (lo_ + ch) : NITEMS;
          ITEM_STREAM(DEC_P0, lo_, 1, hi_, lane); }
#undef DEC_P0
        { const float *wp = ap->in[4], *ps = ap->in[5]; bf16_t* WPS = WSP(bf16_t, WS_WPS); for (int i = bx * 512 + tid; i < 4 * 256 * 256; i += G * 512) WPS[i] = f2bf(wp[i] * ps[(i >> 16) * 256 + (i & 255)]); }
        { const float* wsp = ap->in[9]; bf16_t* WSb = WSP(bf16_t, WS_WSB); for (int i = bx * 512 + tid; i < 8 * 128 * 128; i += G * 512) { const int sidx = i & 127, t = (i >> 7) & 127; WSb[i] = f2bf(((sidx >> 6) <= (t >> 6)) ? wsp[i] : 0.f); } }
        { const float *wrg = ap->in[16], *wre = ap->in[18], *gf = ap->in[15]; bf16_t *WRh = WSP(bf16_t, WS_WRH), *WRl = WSP(bf16_t, WS_WRL);
          for (int i = bx * 512 + tid; i < 48 * D; i += G * 512) { const int o = i / D, k = i % D; float w = 0.f;
              if (o < 4) w = wrg[k * 4 + o]; else if (o < 36) w = wre[((size_t)((o - 4) >> 3) * D + k) * 8 + ((o - 4) & 7)];
              w *= gf[k]; const bf16_t h = f2bf(w); WRh[i] = h; WRl[i] = f2bf(w - bf2f(h)); } }
        { const float* pin = ap->in[1]; bf16_t* PB = WSP(bf16_t, WS_PB); for (long i = (long)(bx * 512 + tid) * 4; i < (long)T * PLE; i += (long)G * 512 * 4) { const f32x4 v = *(const f32x4*)(pin + i); u32x2 o; o.x = pk2(v[0], v[1]); o.y = pk2(v[2], v[3]); *(u32x2*)(PB + i) = o; } }
        { const float* x = ap->in[0]; bf16_t* XN = WSP(bf16_t, WS_XN); unsigned char* XNQ = WSP(unsigned char, WS_XNQ); float* rs0 = WSP(float, WS_RSTD0);
          for (int m = gw; m < T; m += NGW) rms_row_q(x + (size_t)m * D, XN + (size_t)m * D, XNQ + (size_t)m * D, rs0 + m, lane); }
    }
    }
    SEAM(0);
    for (int rep_ = 0; rep_ < REPS(1); ++rep_) { if (rep_) xcd_barrier(bar, wave_s);
    if (IN(1)) {
        const int p = (bx >> 3) & 7;
#define P1_Z(i0_, i1_) { PHASE_BEGIN \
          pg8::SchedDense S{D * 2u, D * 2u, T / 256, PW / 256, G, bx, (i0_), (i1_)}; \
          pg8::EpiP1 E{WSP(bf16_t, WS_AIN), WSP(bf16_t, WS_UU), WSP(bf16_t, WS_GV), WSP(bf16_t, WS_GATES), ap->in[13], 1.f, WSP(float, WS_RSTD0), WSP(float, WS_LNS)}; \
          pg8::gemm_phase<pg8::EpiP1, pg8::SchedDense, true, false>(lds + RING_OFF, WSP(const char, WS_XN), WSP(const char, WS_W1T), D * 2u, D * 2u, D / 64, 0, S, E, tid); }
#define P1_G(i0_, i1_) { PHASE_BEGIN \
          pg8::SchedDense S{(unsigned)D, (unsigned)D, T / 256, (2 * SW + 2 * D) / 256, G, bx, (i0_), (i1_), PW / 256}; \
          pg8::EpiP1 E{WSP(bf16_t, WS_AIN), WSP(bf16_t, WS_UU), WSP(bf16_t, WS_GV), WSP(bf16_t, WS_GATES), ap->in[13], 1.f / WGU_SCALE, WSP(float, WS_RSTD0), WSP(float, WS_LNS)}; \
          pg8::gemm_phase<pg8::EpiP1, pg8::SchedDense, true, false, true>(lds + RING_OFF, WSP(const char, WS_XNQ), WSP(const char, WS_WMGQ), (unsigned)D, (unsigned)D, D / 128, 0, S, E, tid); }
#define P1_SLOT() { PHASE_BEGIN \
          constexpr int NX = 2 * NE * (D / 64) * (DE / 64) + NE * (DE / 64) * (D / 64);     \
          const int ch = (NX + NGW - 1) / NGW, lo_ = gw * ch, hi_ = (lo_ + ch) < NX ? (lo_ + ch) : NX;     \
          ITEM_STREAM(DEC_X, lo_, 1, hi_, lane); \
          VM_WAIT(); __syncthreads(); }
#define DEC_X(r_in, d) do { int r = (r_in); \
          if (item_try(r, d, ap->in[20], D, DE, NE, (long)D * DE, (long)1024 * D, WSP(bf16_t, WS_WGUT), 1, 0, ap->in[15], WGU_SCALE, 1)) break;     \
          if (item_try(r, d, ap->in[21], D, DE, NE, (long)D * DE, (long)1024 * D, WSP(bf16_t, WS_WGUT), 2, 0, ap->in[15], WGU_SCALE, 1)) break; \
          item_try(r, d, ap->in[22], DE, D, NE, (long)DE * D, (long)D * DE, WSP(bf16_t, WS_WDT), 0, 0, nullptr, WD_SCALE, 1); } while (0)
        if (bx < 32) { PHASE_BEGIN
          const int g = bx >> 3, pm = bx & 7;
          pg8::SchedOne S; S.u0.A = (unsigned)(((size_t)pm * 256 * PW + g * 256) * 2); S.u0.B = (unsigned)g * 65536u * 2u; S.u0.rows = nullptr; S.u0.pm = pm; S.u0.pn = g; S.u0.flags = 0; S.u0.mvalid = 256;
          pg8::EpiBf16S E{WSP(bf16_t, WS_W2T), PW, nullptr};
          pg8::gemm_phase<pg8::EpiBf16S, pg8::SchedOne, true, false>(lds + RING_OFF, WSP(const char, WS_WAT), WSP(const char, WS_WPS), PW * 2u, 256 * 2u, 4, 0, S, E, tid); }
        if (p == 0) { P1_SLOT() P1_Z(0, 1 << 30) P1_G(0, 1 << 30) }
        else { P1_Z(0, 1 << 30) P1_G(0, p - 1) P1_SLOT() P1_G(p - 1, 1 << 30) }
#undef P1_Z
#undef P1_G
#undef P1_SLOT
#undef DEC_X
    }
    }
    SEAM(1);
    for (int rep_ = 0; rep_ < REPS(2); ++rep_) { if (rep_) xcd_barrier(bar, wave_s);
    if (IN(2)) {
        for (int L = bx; L < (T / 256) * 4; L += G) { PHASE_BEGIN
            const int pm = L >> 2, g = L & 3;
            bf16_t* ZP = (bf16_t*)out;
            zp_block(WSP(bf16_t, WS_AIN), ZP, pm, g, tid); }
        for (int L = bx; L < (T / 128) * 2; L += G) { PHASE_BEGIN
            bf16_t* SB = (bf16_t*)out + (size_t)2 * T * PW;
            sgu_unit(lds + RING_OFF, WSP(float, WS_LNS), WSP(bf16_t, WS_GV), WSP(bf16_t, WS_UU), WSP(bf16_t, WS_WSB), ap->in[10], ap->in[7], ap->in[8], SB, L >> 1, L & 1, tid); }
    }
    }
    SEAM(2);
    for (int rep_ = 0; rep_ < REPS(3); ++rep_) { if (rep_) xcd_barrier(bar, wave_s);
    if (IN(3)) {
        { PHASE_BEGIN
          const char* ZPc = (const char*)out;
          pg8::SchedDual S{(unsigned)((size_t)2 * T * PW * 2), (unsigned)(WS_WBT - WS_W2T), PW * 2u, PW * 2u, T / 256, D / 256, G, bx};
          pg8::EpiMerge E{WSP(bf16_t, WS_GATES), WSP(bf16_t, WS_MG)};
          pg8::gemm_phase<pg8::EpiMerge, pg8::SchedDual, true, false>(lds + RING_OFF, ZPc, WSP(const char, WS_W2T), PW * 2u, PW * 2u, PW / 64, 0, S, E, tid); }
        { PHASE_BEGIN
          pg8::SchedDense S{PLE * 2u, PLE * 2u, T / 256, D / 256, G, bx};
          pg8::EpiBf16S E{WSP(bf16_t, WS_PU), D, nullptr};
          pg8::gemm_phase<pg8::EpiBf16S, pg8::SchedDense, true, false>(lds + RING_OFF, WSP(const char, WS_PB), WSP(const char, WS_WPUT), PLE * 2u, PLE * 2u, PLE / 64, 0, S, E, tid); }
    }
    }
    SEAM(3);
    for (int rep_ = 0; rep_ < REPS(4); ++rep_) { if (rep_) xcd_barrier(bar, wave_s);
    if (IN(4)) { PHASE_BEGIN
        pg8::SchedDense S{D * 2u, D * 2u, T / 256, D / 256, G, bx};
        pg8::EpiResBf16 E{WSP(bf16_t, WS_XN), (unsigned char*)out};
        pg8::gemm_phase<pg8::EpiResBf16, pg8::SchedDense, true, false>(lds + RING_OFF, WSP(const char, WS_MG), WSP(const char, WS_WOT), D * 2u, D * 2u, D / 64, 0, S, E, tid);
    }
    }
    SEAM(4);
    if (IN(5)) {
        for (int grp = bx; grp < T / 64; grp += G) { PHASE_BEGIN
            router_group(lds + RING_OFF, WSP(bf16_t, WS_XN), WSP(bf16_t, WS_WRH), WSP(bf16_t, WS_WRL), ap->in[17], ap->in[19], WSP(float, WS_EW), WSP(float, WS_RSTD), WSP(int, WS_CTL), WSP(int, WS_LIST), grp, tid); }
    }
    SEAM(5);
    for (int rep_ = 0; rep_ < REPS(6); ++rep_) { if (rep_) xcd_barrier(bar, wave_s);
    if (IN(6)) { PHASE_BEGIN
        moe_tables(pre, cl, WSP(int, WS_CTL), tid);
        pg8::SchedMoe S{1024u * D, (unsigned)D, WSP(int, WS_LIST), pre, cl, 4, G, vcu, WSP(unsigned, WS_MOERDY), 1, wave};
        pg8::EpiMoe1 E{WSP(unsigned char, WS_HID), WSP(float, WS_RSTD)};
        pg8::gemm_phase<pg8::EpiMoe1, pg8::SchedMoe, true, true, true>(lds + RING_OFF, out, WSP(const char, WS_WGUT), (unsigned)D, (unsigned)D, D / 128, 1, S, E, tid);
    }
    }
    for (int rep_ = 0; rep_ < REPS(7); ++rep_) { if (rep_) xcd_barrier(bar, wave_s);
    if (IN(7)) { PHASE_BEGIN
        moe_tables(pre, cl, WSP(int, WS_CTL), tid);
        const int r1 = (__builtin_amdgcn_readfirstlane(pre[32]) * 4) % G;
        pg8::SchedMoe S{(unsigned)D * DE, (unsigned)DE, WSP(int, WS_LIST), pre, cl, 8, G, vcu, WSP(unsigned, WS_MOERDY), 2, wave, r1, 1};
        pg8::EpiMoe2 E{WSP(unsigned char, WS_Y), WSP(float, WS_EW)};
        pg8::gemm_phase<pg8::EpiMoe2, pg8::SchedMoe, true, true, true>(lds + RING_OFF, WSP(const char, WS_HID), WSP(const char, WS_WDT), (unsigned)DE, (unsigned)DE, DE / 128, 0, S, E, tid);
    }
    }
    SEAM(7);
    if (IN(8)) { PHASE_BEGIN
        const unsigned char* Y = WSP(unsigned char, WS_Y); bf16_t *XB = WSP(bf16_t, WS_XN), *X2 = WSP(bf16_t, WS_X2B); unsigned char* X2Q = WSP(unsigned char, WS_X2Q); float* rs2 = WSP(float, WS_RSTD2);
        for (int m = gw; m < T; m += NGW) x2_row(XB + (size_t)m * D, Y + (size_t)(2 * m) * D, Y + (size_t)(2 * m + 1) * D, X2 + (size_t)m * D, X2Q + (size_t)m * D, rs2 + m, lane);
    }
    SEAM(8);
    if (IN(9)) { PHASE_BEGIN
        pg8::SchedPanel S{(unsigned)D, (unsigned)D, T / 256, G, vcu};
        pg8::EpiPleFinal E{WSP(bf16_t, WS_X2B), WSP(float, WS_RSTD2), ap->in[25], WSP(bf16_t, WS_PU), ap->in[27], out, WSP(float, WS_SSQ), WSP(unsigned, WS_PCNT)};
        pg8::gemm_phase<pg8::EpiPleFinal, pg8::SchedPanel, true, false, true>(lds + RING_OFF, WSP(const char, WS_X2Q), WSP(const char, WS_WPGT), (unsigned)D, (unsigned)D, D / 128, 0, S, E, tid);
    }
#undef IN
#undef SEAM
}


static int g_grid = 0;
extern "C" void kernel_launch(void* const* d_in, const int* in_sizes, int n_in, void* d_out, int out_size, void* d_ws, size_t ws_size, hipStream_t stream) {
    if (g_grid == 0) {
        if (n_in != 28 || in_sizes[0] != T * D || out_size != T * D || ws_size < WS_END2) { fprintf(stderr, "kernel_launch: unexpected shapes (n_in %d, in0 %d, out %d, ws %zu)\n", n_in, n_in > 0 ? in_sizes[0] : -1, out_size, ws_size); g_grid = -1; return; }
        int dev = 0, cus = 0, per_cu = 0;
        if (hipGetDevice(&dev) != hipSuccess || hipDeviceGetAttribute(&cus, hipDeviceAttributeMultiprocessorCount, dev) != hipSuccess) { fprintf(stderr, "kernel_launch: device query failed\n"); g_grid = -1; return; }
        if (hipFuncSetAttribute((const void*)mk_fwd, hipFuncAttributeMaxDynamicSharedMemorySize, LDS_BYTES) != hipSuccess) { fprintf(stderr, "kernel_launch: hipFuncSetAttribute failed\n"); g_grid = -1; return; }
        if (hipOccupancyMaxActiveBlocksPerMultiprocessor(&per_cu, (const void*)mk_fwd, NWAVES * 64, LDS_BYTES) != hipSuccess || per_cu < 1) { fprintf(stderr, "kernel_launch: occupancy query says %d workgroups per CU\n", per_cu); g_grid = -1; return; }
        g_grid = cus & ~7;
        if (g_grid < 8) { fprintf(stderr, "kernel_launch: %d CUs?\n", cus); g_grid = -1; return; }
    }
    if (g_grid < 0) return;
    (void)hipMemsetAsync((unsigned char*)d_ws + WS_CTL, 0, 1 * MiB, stream);
    Args a{};
    for (int i = 0; i < 28; ++i) a.in[i] = (const float*)d_in[i];
    a.out = (float*)d_out; a.ws = (unsigned char*)d_ws; a.ph_lo = 0; a.ph_hi = N_PHASES; a.li = 0; a.pad = 0;
#ifndef SPLIT_REPEAT
#define SPLIT_REPEAT 1
#endif
#ifdef SPLIT_AT
    a.ph_hi = SPLIT_AT + SPLIT_REPEAT;
    hipLaunchKernelGGL(mk_fwd, dim3(g_grid), dim3(NWAVES * 64), LDS_BYTES, stream, a);
    a.ph_lo = SPLIT_AT; a.ph_hi = N_PHASES; a.li = 1;
    if (SPLIT_AT == 5) (void)hipMemsetAsync((unsigned char*)d_ws + WS_CTL, 0, 128, stream);
#endif
    hipLaunchKernelGGL(mk_fwd, dim3(g_grid), dim3(NWAVES * 64), LDS_BYTES, stream, a);
#ifdef RUN_TWICE
    (void)hipMemsetAsync((unsigned char*)d_ws + WS_CTL, 0, 1 * MiB, stream);
    hipLaunchKernelGGL(mk_fwd, dim3(g_grid), dim3(NWAVES * 64), LDS_BYTES, stream, a);
#endif
}
```

```cpp
#include <hip/hip_runtime.h>
#include <stdint.h>
#include <stdio.h>

typedef unsigned short bf16_t;
#define DEV __device__ __forceinline__

DEV float bf2f(bf16_t v) { return __uint_as_float(((unsigned)v) << 16); }
DEV bf16_t f2bf(float f) { unsigned u = __float_as_uint(f); return (bf16_t)((u + 0x7fffu + ((u >> 16) & 1u)) >> 16); }
DEV float sigmoidf_(float x) { return 1.f / (1.f + __expf(-x)); }
DEV float gelu_tanh(float x) { const float u = 0.7978845608028654f * (x + 0.044715f * x * x * x); return x / (1.f + __expf(-2.f * u)); }
DEV float silu_(float x) { return x / (1.f + __expf(-x)); }

constexpr int T = 16384, D = 2048, SEQ = 4096, NIN = 3072, N1 = 7168, PW = 1024, SW = 1024, NE = 32, DE = 512, PLE = 256;
constexpr int CAP = 16384;
constexpr float EPS = 1e-6f;
constexpr float WGU_SCALE = 256.f, WD_SCALE = 128.f, HID_SCALE = 8.f, Y_SCALE = 16.f;

constexpr size_t MiB = 1u << 20;
constexpr size_t WS_CTL = 0;
constexpr size_t WS_SSQ = 256 * 1024;
constexpr size_t WS_PCNT = 512 * 1024;
constexpr size_t WS_MOERDY = 768 * 1024;
constexpr size_t WS_EID = 1 * MiB;
constexpr size_t WS_EW = 2 * MiB;
constexpr size_t WS_RSTD = 3 * MiB;
constexpr size_t WS_RSTD0 = 3 * MiB + 256 * 1024;
constexpr size_t WS_RSTD2 = 3 * MiB + 512 * 1024;
constexpr size_t WS_LIST = 4 * MiB;
constexpr size_t WS_WRH = 6 * MiB;
constexpr size_t WS_WRL = 7 * MiB;
constexpr size_t WS_W1T = 8 * MiB;
constexpr size_t WS_LNS = 20 * MiB;
constexpr size_t WS_W2T = 24 * MiB;
constexpr size_t WS_WPS = 30 * MiB;
constexpr size_t WS_WPT = 36 * MiB;
constexpr size_t WS_WSB = 36 * MiB + 512 * 1024;
constexpr size_t WS_WAT = 37 * MiB;
constexpr size_t WS_WBT = 41 * MiB;
constexpr size_t WS_WOT = 45 * MiB;
constexpr size_t WS_WPGT = 53 * MiB;
constexpr size_t WS_WPUT = 61 * MiB;
constexpr size_t WS_WGUT = 62 * MiB;
constexpr size_t WS_WDT = 190 * MiB;
constexpr size_t WS_PB = 254 * MiB;
constexpr size_t WS_XN = 262 * MiB;
constexpr size_t WS_AIN = 326 * MiB;
constexpr size_t WS_UU = 358 * MiB;
constexpr size_t WS_GV = 390 * MiB;
constexpr size_t WS_GATES = 422 * MiB;
constexpr size_t WS_MG = WS_AIN;
constexpr size_t WS_HID = WS_GV;
constexpr size_t WS_Y = WS_GATES;
constexpr size_t WS_X2B = WS_WGUT + 64 * MiB;
constexpr size_t WS_X2Q = WS_WDT + 32 * MiB;
constexpr size_t WS_XNQ = WS_X2B;
constexpr size_t WS_WMGQ = WS_X2Q;
constexpr size_t WS_END = 550 * MiB;
constexpr size_t OUT_X2B = 32 * MiB, OUT_X2Q = 96 * MiB;

#define LAS __attribute__((address_space(3)))
#define GAS __attribute__((address_space(1)))
typedef short bf16x8 __attribute__((ext_vector_type(8)));
typedef float f32x4 __attribute__((ext_vector_type(4)));
typedef float f32x2 __attribute__((ext_vector_type(2)));
typedef unsigned u32x4 __attribute__((ext_vector_type(4)));
typedef unsigned u32x2 __attribute__((ext_vector_type(2)));

namespace pg8 {
constexpr int BM = 256, BK = 64, HALF = 128, HTB = HALF * BK * 2, STAGE_BYTES = 8 * HTB, NXCD = 8, WGM = 8;
__host__ __device__ __forceinline__ int lds_byte(int r, int c) { const int st = (r >> 4) * 2 + (c >> 5), rr = r & 15, cc = c & 31, ob = rr * 64 + cc * 2; return st * 1024 + (ob ^ (((ob >> 9) & 1) << 5)); }
__host__ __device__ __forceinline__ void stage_rc(int b, int& R, int& C) { const int st = b / 1024, sb = b % 1024, swz = sb ^ (((sb >> 9) & 1) << 5); R = (st >> 1) * 16 + swz / 64; C = (st & 1) * 32 + (swz % 64) / 2; }
__host__ __device__ __forceinline__ int perm32(int rho) { const int n = rho >> 4, i = rho & 15; return 8 * (i >> 2) + 4 * n + (i & 3); }

enum { U_KEEP = 1 };
struct Unit { unsigned A; unsigned B; const int* rows; int pm, pn, flags, mvalid; };

DEV bool static_tile(int i, int G, int c, int nM, int nN, int& pm, int& pn) {
    const int nwg = nM * nN; const long L = (long)i * G + c; if (L >= nwg) return false;
    int wgid = (int)L; { const int q = nwg / NXCD, r = nwg % NXCD, xcd = wgid % NXCD, off = wgid / NXCD; wgid = (xcd < r ? xcd * (q + 1) : r * (q + 1) + (xcd - r) * q) + off; }
    const int nig = WGM * nN, gid = wgid / nig, fm = gid * WGM, gsz = (nM - fm) < WGM ? (nM - fm) : WGM;
    pm = fm + ((wgid % nig) % gsz); pn = (wgid % nig) / gsz; return true;
}
DEV unsigned cvt_pk_bf16(float lo, float hi) { unsigned r; asm volatile("v_cvt_pk_bf16_f32 %0, %1, %2" : "=v"(r) : "v"(lo), "v"(hi)); return r; }
DEV float fast_rcp(float x) { return __builtin_amdgcn_rcpf(x); }
DEV float fast_exp(float x) { return __builtin_amdgcn_exp2f(x * 1.4426950408889634f); }
DEV float sigm(float x) { return fast_rcp(1.f + fast_exp(-x)); }
DEV float gelu_t(float x) { const float u = 1.5957691216057308f * (x + 0.044715f * x * x * x); return x * fast_rcp(1.f + fast_exp(-u)); }
DEV float silu_f(float x) { return x * fast_rcp(1.f + fast_exp(-x)); }
typedef int i32x8 __attribute__((ext_vector_type(8)));
typedef int i32x4 __attribute__((ext_vector_type(4)));
DEV unsigned pk4_fp8(float a, float b, float c, float d) { int w = __builtin_amdgcn_cvt_pk_fp8_f32(a, b, 0, false); w = __builtin_amdgcn_cvt_pk_fp8_f32(c, d, w, true); return (unsigned)w; }
DEV float clamp448(float v) { return __builtin_fminf(__builtin_fmaxf(v, -448.f), 448.f); }

template <class Epi, class Sched, bool ALIGN_EPI, bool GATHER, bool FP8 = false>
DEV void gemm_phase(LAS unsigned char* lds, const void* Abase, const void* Bbase, const unsigned lda, const unsigned ldb, const int nt_in, const int gshift, const Sched& S, const Epi& E, const int tid) {
    int nt = nt_in; asm volatile("" : "+s"(nt));
    const int wid = __builtin_amdgcn_readfirstlane(tid >> 6), lane = tid & 63, wr = wid >> 2, wc = wid & 3, fr = lane & 15, fq = lane >> 4;
    unsigned voffA[2], voffB[2];
#pragma unroll
    for (int i = 0; i < 2; ++i) { int R, C; stage_rc(tid * 16 + i * 8192, R, C); const int Rb = Epi::PERM ? ((R & ~31) + perm32(R & 31)) : R;
        voffA[i] = (unsigned)R * lda + (unsigned)C * 2u; voffB[i] = (unsigned)Rb * ldb + (unsigned)C * 2u; }
    const unsigned kstep = BK * 2u;
    const unsigned hstepA = HALF * lda, hstepB = HALF * ldb;
    const __amdgpu_buffer_rsrc_t rA = __builtin_amdgcn_make_buffer_rsrc(const_cast<void*>(Abase), 0, 0x7fffffff, 0x00020000), rB = __builtin_amdgcn_make_buffer_rsrc(const_cast<void*>(Bbase), 0, 0x7fffffff, 0x00020000);
    const unsigned ldsw = (unsigned)wid * 1024u;
    const int aoff = lds_byte(wr * 64 + fr, fq * 8), boff = lds_byte(wc * 32 + fr, fq * 8);
#define PG8_SA(b, h) (((b) * 2 + (h)) * HTB)
#define PG8_SB(b, h) ((4 + (b) * 2 + (h)) * HTB)
#define PG8_STG(bufoff, rs, voff, soff) do { _Pragma("unroll") for (int _i = 0; _i < 2; ++_i) \
        __builtin_amdgcn_raw_ptr_buffer_load_lds(rs, (LAS void*)(lds + (bufoff) + ldsw + _i * 8192), 16, (int)(voff)[_i], (int)(soff), 0, 0); } while (0)
#define PG8_STAGE_B(bufoff, soff) PG8_STG(bufoff, rB, voffB, soff)
#define PG8_STAGE_A(bufoff, soff, h) do { if constexpr (GATHER) { PG8_STG(bufoff, rA, gAc[h], soff); } else { PG8_STG(bufoff, rA, voffA, (soff) + (h) * hstepA); } } while (0)
#define PG8_LDA(dst, b, h) do { _Pragma("unroll") for (int m = 0; m < 4; ++m) _Pragma("unroll") for (int k = 0; k < 2; ++k) dst[m][k] = *(const LAS bf16x8*)(lds + PG8_SA(b, h) + aoff + m * 2048 + k * 1024); } while (0)
#define PG8_LDB(dst, b, h) do { _Pragma("unroll") for (int n = 0; n < 2; ++n) _Pragma("unroll") for (int k = 0; k < 2; ++k) dst[n][k] = *(const LAS bf16x8*)(lds + PG8_SB(b, h) + boff + n * 2048 + k * 1024); } while (0)
#define PG8_CAT(x, y) __builtin_shufflevector(__builtin_bit_cast(i32x4, x), __builtin_bit_cast(i32x4, y), 0, 1, 2, 3, 4, 5, 6, 7)
#define PG8_MMA(ai, bj, At, Bt) do { __builtin_amdgcn_s_setprio(1); _Pragma("unroll") for (int m = 0; m < 4; ++m) _Pragma("unroll") for (int n = 0; n < 2; ++n) { \
        if constexpr (FP8) acc[ai][bj][m][n] = __builtin_amdgcn_mfma_scale_f32_16x16x128_f8f6f4(PG8_CAT(Bt[n][0], Bt[n][1]), PG8_CAT(At[m][0], At[m][1]), acc[ai][bj][m][n], 0, 0, 0, 0, 0, 0); \
        else { _Pragma("unroll") for (int k = 0; k < 2; ++k) acc[ai][bj][m][n] = __builtin_amdgcn_mfma_f32_16x16x32_bf16(Bt[n][k], At[m][k], acc[ai][bj][m][n], 0, 0, 0); } } __builtin_amdgcn_s_setprio(0); } while (0)
#define PG8_WAIT_V(n) asm volatile("s_waitcnt vmcnt(" #n ")" ::: "memory")
#define PG8_WAIT_L(n) asm volatile("s_waitcnt lgkmcnt(" #n ")" ::: "memory")
#define PG8_BAR __builtin_amdgcn_s_barrier()
#define PG8_SCHED __builtin_amdgcn_sched_barrier(0)
    Unit cur, nxt; int ui = 0;
    if (!S.next(0, cur)) return;
    f32x4 acc[2][2][4][2];
#pragma unroll
    for (int a = 0; a < 2; ++a)
#pragma unroll
        for (int b = 0; b < 2; ++b)
#pragma unroll
            for (int m = 0; m < 4; ++m)
#pragma unroll
                for (int n = 0; n < 2; ++n) acc[a][b][m][n] = (f32x4){0.f, 0.f, 0.f, 0.f};
    bf16x8 At[4][2], B0[2][2], B1[2][2];
    unsigned gAc[2][2], gAn[2][2];
#define PG8_LOADROWS(u, dst) do { if constexpr (GATHER) { _Pragma("unroll") for (int h = 0; h < 2; ++h) _Pragma("unroll") for (int i = 0; i < 2; ++i) { int R, C; stage_rc(tid * 16 + i * 8192, R, C); \
        const int idx = h * HALF + R; const int e = (u).rows[idx < (u).mvalid ? idx : 0]; dst[h][i] = (unsigned)(e >> gshift) * lda + (unsigned)C * 2u; } } } while (0)
    PG8_LOADROWS(cur, gAc);
    unsigned cA = cur.A, cB = cur.B;
    S.a_ready(cur);
    PG8_STAGE_B(PG8_SB(0, 0), cB); PG8_STAGE_B(PG8_SB(0, 1), cB + hstepB); PG8_STAGE_A(PG8_SA(0, 0), cA, 0); PG8_STAGE_A(PG8_SA(0, 1), cA, 1);
    if (wr == 1) PG8_BAR;
    PG8_WAIT_V(2); PG8_BAR;
    PG8_STAGE_B(PG8_SB(1, 0), cB + kstep); PG8_STAGE_A(PG8_SA(1, 0), cA + kstep, 0); PG8_STAGE_B(PG8_SB(1, 1), cB + hstepB + kstep);
    PG8_WAIT_V(6); PG8_BAR;
    for (;;) {
        const bool has_next = S.next(ui + 1, nxt);
        if (has_next) { PG8_LOADROWS(nxt, gAn); } else if constexpr (GATHER) { _Pragma("unroll") for (int h = 0; h < 2; ++h) _Pragma("unroll") for (int i = 0; i < 2; ++i) gAn[h][i] = gAc[h][i]; }
        const unsigned nA = has_next ? nxt.A : cA, nB = has_next ? nxt.B : cB;
        for (int t = 0; t < nt; t += 2) {
            const bool last = (t == nt - 2);
            const unsigned a1 = cA + (unsigned)(t + 1) * kstep;
            const unsigned a2 = last ? nA : cA + (unsigned)(t + 2) * kstep, b2 = last ? nB : cB + (unsigned)(t + 2) * kstep;
            const unsigned a3 = a2 + kstep, b3 = b2 + kstep;
            if (last && has_next) S.a_ready(nxt);
            PG8_LDB(B0, 0, 0); PG8_LDB(B1, 0, 1); PG8_SCHED; PG8_LDA(At, 0, 0); PG8_STAGE_A(PG8_SA(1, 1), a1, 1);
            if constexpr (GATHER) { if (last) { _Pragma("unroll") for (int h = 0; h < 2; ++h) _Pragma("unroll") for (int i = 0; i < 2; ++i) gAc[h][i] = gAn[h][i]; } }
            PG8_WAIT_V(8); PG8_WAIT_L(0); PG8_BAR; PG8_MMA(0, 0, At, B0); PG8_MMA(0, 1, At, B1); PG8_BAR; PG8_SCHED;
            PG8_LDA(At, 0, 1); PG8_STAGE_B(PG8_SB(0, 0), b2); PG8_STAGE_B(PG8_SB(0, 1), b2 + hstepB); PG8_STAGE_A(PG8_SA(0, 0), a2, 0);
            PG8_WAIT_V(8); PG8_WAIT_L(0); PG8_BAR; PG8_MMA(1, 0, At, B0); PG8_MMA(1, 1, At, B1); PG8_BAR; PG8_SCHED;
            PG8_LDB(B0, 1, 0); PG8_LDB(B1, 1, 1); PG8_SCHED; PG8_LDA(At, 1, 0); PG8_STAGE_A(PG8_SA(0, 1), a2, 1);
            PG8_WAIT_V(8); PG8_WAIT_L(0); PG8_BAR; PG8_MMA(0, 0, At, B0); PG8_MMA(0, 1, At, B1); PG8_BAR; PG8_SCHED;
            PG8_LDA(At, 1, 1); PG8_STAGE_B(PG8_SB(1, 0), b3); PG8_STAGE_B(PG8_SB(1, 1), b3 + hstepB); PG8_STAGE_A(PG8_SA(1, 0), a3, 0);
            PG8_WAIT_V(8); PG8_WAIT_L(0); PG8_BAR; PG8_MMA(1, 0, At, B0); PG8_MMA(1, 1, At, B1); PG8_BAR; PG8_SCHED;
        }
        if constexpr (ALIGN_EPI) { if (wr == 0) PG8_BAR; }
        { int l_e; asm volatile("v_mbcnt_lo_u32_b32 %0, -1, 0\n\tv_mbcnt_hi_u32_b32 %0, -1, %0" : "=v"(l_e));
          E(acc, cur, wr, wc, l_e & 15, l_e >> 4); }
        S.done(cur);
        if (!(cur.flags & U_KEEP)) {
#pragma unroll
            for (int a = 0; a < 2; ++a)
#pragma unroll
                for (int b = 0; b < 2; ++b)
#pragma unroll
                    for (int m = 0; m < 4; ++m)
#pragma unroll
                        for (int n = 0; n < 2; ++n) acc[a][b][m][n] = (f32x4){0.f, 0.f, 0.f, 0.f};
        }
        if (!has_next) break;
        cur = nxt; cA = nA; cB = nB; ++ui;
        if constexpr (ALIGN_EPI) { if (wr == 1) PG8_BAR; }
    }
    PG8_WAIT_V(0);
    if constexpr (!ALIGN_EPI) { if (wr == 0) PG8_BAR; }
    PG8_BAR;
#undef PG8_SA
#undef PG8_SB
#undef PG8_STG
#undef PG8_STAGE_A
#undef PG8_STAGE_B
#undef PG8_LDA
#undef PG8_LDB
#undef PG8_MMA
#undef PG8_CAT
#undef PG8_WAIT_V
#undef PG8_WAIT_L
#undef PG8_BAR
#undef PG8_SCHED
#undef PG8_LOADROWS
}

typedef f32x4 Acc[2][2][4][2];
DEV u32x4 pack8(const f32x4 v0, const f32x4 v1) { u32x4 w; w.x = cvt_pk_bf16(v0[0], v0[1]); w.y = cvt_pk_bf16(v0[2], v0[3]); w.z = cvt_pk_bf16(v1[0], v1[1]); w.w = cvt_pk_bf16(v1[2], v1[3]); return w; }
DEV void unpack8(const u32x4 w, f32x4& v0, f32x4& v1) {
    v0[0] = __uint_as_float(w.x << 16); v0[1] = __uint_as_float(w.x & 0xffff0000u); v0[2] = __uint_as_float(w.y << 16); v0[3] = __uint_as_float(w.y & 0xffff0000u);
    v1[0] = __uint_as_float(w.z << 16); v1[1] = __uint_as_float(w.z & 0xffff0000u); v1[2] = __uint_as_float(w.w << 16); v1[3] = __uint_as_float(w.w & 0xffff0000u); }

struct EpiP1 {
    static constexpr bool PERM = true;
    bf16_t *AIN, *UU, *GV, *GATES; const float* bmg; float gsc;
    const float* rstd0;
    float* lns;
    DEV void operator()(Acc& acc, const Unit& u, int wr, int wc, int fr, int fq) const {
        const int pn = u.pn; int mode, ld, ct; bf16_t* base;
        if (pn < 4) { mode = 0; base = AIN; ld = 1024; ct = pn * 256; } else if (pn < 8) { mode = 1; base = UU; ld = 1024; ct = (pn - 4) * 256; }
        else if (pn < 12) { mode = 1; base = GV; ld = 1024; ct = (pn - 8) * 256; } else { mode = 2; base = GATES; ld = 4096; ct = (pn - 12) * 256; }
        const int row0 = u.pm * BM + wr * 64 + fr, col0 = ct + wc * 32 + 8 * fq;
        f32x4 bv[2][2];
#pragma unroll
        for (int bj = 0; bj < 2; ++bj)
#pragma unroll
            for (int n = 0; n < 2; ++n) bv[bj][n] = (mode == 2) ? *(const f32x4*)(bmg + col0 + bj * HALF + 4 * n) : (f32x4){0.f, 0.f, 0.f, 0.f};
        float rs[2][4];
#pragma unroll
        for (int ai = 0; ai < 2; ++ai)
#pragma unroll
            for (int m = 0; m < 4; ++m) rs[ai][m] = rstd0[row0 + ai * HALF + m * 16] * gsc;
#pragma unroll
        for (int ai = 0; ai < 2; ++ai)
#pragma unroll
            for (int m = 0; m < 4; ++m) { bf16_t* rowp = base + (size_t)(row0 + ai * HALF + m * 16) * ld + col0; float s1 = 0.f, s2 = 0.f;
#pragma unroll
                for (int bj = 0; bj < 2; ++bj) { f32x4 v0 = acc[ai][bj][m][0] * rs[ai][m] + bv[bj][0], v1 = acc[ai][bj][m][1] * rs[ai][m] + bv[bj][1];
                    if (mode == 1) {
#pragma unroll
                        for (int j = 0; j < 4; ++j) { v0[j] = gelu_t(v0[j]); v1[j] = gelu_t(v1[j]); } }
                    else if (mode == 2) {
#pragma unroll
                        for (int j = 0; j < 4; ++j) { v0[j] = sigm(v0[j]); v1[j] = sigm(v1[j]); } }
                    if (pn >= 8 && pn < 12) {
#pragma unroll
                        for (int j = 0; j < 4; ++j) { s1 += v0[j] + v1[j]; s2 += v0[j] * v0[j] + v1[j] * v1[j]; } }
                    *(u32x4*)(rowp + bj * HALF) = pack8(v0, v1); }
                if (pn >= 8 && pn < 12) {
                    s1 += __shfl_xor(s1, 16); s2 += __shfl_xor(s2, 16); s1 += __shfl_xor(s1, 32); s2 += __shfl_xor(s2, 32);
                    if (fq == 0) { f32x2 pr; pr.x = s1; pr.y = s2; *(f32x2*)(lns + ((size_t)(row0 + ai * HALF + m * 16) * 16 + (pn - 8) * 4 + wc) * 2) = pr; } } }
    }
};
struct EpiBf16S {
    static constexpr bool PERM = true;
    bf16_t* O; int ld; const float* scale;
    DEV void operator()(Acc& acc, const Unit& u, int wr, int wc, int fr, int fq) const {
        const int row0 = u.pm * BM + wr * 64 + fr, col0 = u.pn * BM + wc * 32 + 8 * fq;
#pragma unroll
        for (int bj = 0; bj < 2; ++bj) {
            f32x4 s0 = (f32x4){1.f, 1.f, 1.f, 1.f}, s1 = s0;
            if (scale) { s0 = *(const f32x4*)(scale + col0 + bj * HALF); s1 = *(const f32x4*)(scale + col0 + bj * HALF + 4); }
#pragma unroll
            for (int ai = 0; ai < 2; ++ai)
#pragma unroll
                for (int m = 0; m < 4; ++m) *(u32x4*)(O + (size_t)(row0 + ai * HALF + m * 16) * ld + col0 + bj * HALF) = pack8(acc[ai][bj][m][0] * s0, acc[ai][bj][m][1] * s1); }
    }
};
struct EpiMerge {
    static constexpr bool PERM = true;
    const bf16_t* GATES; bf16_t* MG;
    DEV void operator()(Acc& acc, const Unit& u, int wr, int wc, int fr, int fq) const {
        const int row0 = u.pm * BM + wr * 64 + fr, col0 = u.pn * BM + wc * 32 + 8 * fq;
        const bool first = (u.flags & U_KEEP) != 0;
#pragma unroll
        for (int ai = 0; ai < 2; ++ai) {
            u32x4 gb[4][2], ga[4][2];
#pragma unroll
            for (int m = 0; m < 4; ++m)
#pragma unroll
                for (int bj = 0; bj < 2; ++bj) { const size_t r = (size_t)(row0 + ai * HALF + m * 16); gb[m][bj] = *(const u32x4*)(GATES + r * 4096 + 2048 + col0 + bj * HALF);
                    if (first) ga[m][bj] = *(const u32x4*)(GATES + r * 4096 + col0 + bj * HALF); }
#pragma unroll
            for (int m = 0; m < 4; ++m)
#pragma unroll
                for (int bj = 0; bj < 2; ++bj) { const size_t r = (size_t)(row0 + ai * HALF + m * 16);
                    f32x4 b0, b1; unpack8(gb[m][bj], b0, b1);
                    if (first) { f32x4 a0, a1; unpack8(ga[m][bj], a0, a1);
#pragma unroll
                        for (int j = 0; j < 4; ++j) { acc[ai][bj][m][0][j] *= a0[j] * fast_rcp(b0[j]); acc[ai][bj][m][1][j] *= a1[j] * fast_rcp(b1[j]); } }
                    else *(u32x4*)(MG + r * 2048 + col0 + bj * HALF) = pack8(acc[ai][bj][m][0] * b0, acc[ai][bj][m][1] * b1); } }
    }
};
struct EpiResBf16 {
    static constexpr bool PERM = true;
    bf16_t* ob; unsigned char* oq;
    DEV void operator()(Acc& acc, const Unit& u, int wr, int wc, int fr, int fq) const {
        const int row0 = u.pm * BM + wr * 64 + fr, col0 = u.pn * BM + wc * 32 + 8 * fq;
#pragma unroll
        for (int ai = 0; ai < 2; ++ai) {
            u32x4 rv[4][2];
#pragma unroll
            for (int m = 0; m < 4; ++m)
#pragma unroll
                for (int bj = 0; bj < 2; ++bj) rv[m][bj] = *(const u32x4*)(ob + (size_t)(row0 + ai * HALF + m * 16) * 2048 + col0 + bj * HALF);
#pragma unroll
            for (int m = 0; m < 4; ++m)
#pragma unroll
                for (int bj = 0; bj < 2; ++bj) { const size_t off = (size_t)(row0 + ai * HALF + m * 16) * 2048 + col0 + bj * HALF; f32x4 r0, r1; unpack8(rv[m][bj], r0, r1);
                    const f32x4 v0 = r0 + acc[ai][bj][m][0], v1 = r1 + acc[ai][bj][m][1];
                    *(u32x4*)(ob + off) = pack8(v0, v1); u32x2 q; q.x = pk4_fp8(v0[0], v0[1], v0[2], v0[3]); q.y = pk4_fp8(v1[0], v1[1], v1[2], v1[3]); *(u32x2*)(oq + off) = q; } }
    }
};
struct EpiPleFinal {
    static constexpr bool PERM = true;
    const bf16_t* X2; const float* rstd; const float* bias; const bf16_t* PU; const float* gfin; float* out; float* ssq; unsigned* pcnt;
    DEV void operator()(Acc& acc, const Unit& u, int wr, int wc, int fr, int fq) const {
        const int row0 = u.pm * BM + wr * 64 + fr, col0 = u.pn * BM + wc * 32 + 8 * fq;
        int zdep = 0;
#pragma unroll
        for (int bj = 0; bj < 2; ++bj) {
            const f32x4 bv0 = *(const f32x4*)(bias + col0 + bj * HALF), bv1 = *(const f32x4*)(bias + col0 + bj * HALF + 4);
#pragma unroll
            for (int ai = 0; ai < 2; ++ai) {
                u32x4 xw[4], pw[4]; float rs[4];
#pragma unroll
                for (int m = 0; m < 4; ++m) { const size_t r = (size_t)(row0 + zdep + ai * HALF + m * 16); rs[m] = rstd[r] * (1.f / WGU_SCALE);
                    xw[m] = *(const u32x4*)(X2 + r * 2048 + col0 + bj * HALF); pw[m] = *(const u32x4*)(PU + r * 2048 + col0 + bj * HALF); }
#pragma unroll
                for (int m = 0; m < 4; ++m) { f32x4 x0, x1, p0, p1; unpack8(xw[m], x0, x1); unpack8(pw[m], p0, p1);
                    f32x4 g0 = acc[ai][bj][m][0] * rs[m] + bv0, g1 = acc[ai][bj][m][1] * rs[m] + bv1;
#pragma unroll
                    for (int q = 0; q < 4; ++q) { g0[q] = sigm(g0[q]); g1[q] = sigm(g1[q]); }
                    acc[ai][bj][m][0] = x0 + g0 * p0; acc[ai][bj][m][1] = x1 + g1 * p1; }
                asm volatile("" : "+v"(zdep), "+v"(acc[ai][bj][0][0]), "+v"(acc[ai][bj][1][0]), "+v"(acc[ai][bj][2][0]), "+v"(acc[ai][bj][3][0]), "+v"(acc[ai][bj][0][1]), "+v"(acc[ai][bj][1][1]), "+v"(acc[ai][bj][2][1]), "+v"(acc[ai][bj][3][1])); } }
        float sqv[2][4];
#pragma unroll
        for (int ai = 0; ai < 2; ++ai)
#pragma unroll
            for (int m = 0; m < 4; ++m) { float sq = 0.f;
#pragma unroll
                for (int bj = 0; bj < 2; ++bj)
#pragma unroll
                    for (int n = 0; n < 2; ++n) { const f32x4 v = acc[ai][bj][m][n]; sq += (v[0] * v[0] + v[1] * v[1]) + (v[2] * v[2] + v[3] * v[3]); }
                sq += __shfl_xor(sq, 16); sq += __shfl_xor(sq, 32); sqv[ai][m] = sq; }
        if (fq == 0) {
#pragma unroll
            for (int ai = 0; ai < 2; ++ai)
#pragma unroll
                for (int m = 0; m < 4; ++m) atomicAdd(ssq + row0 + ai * HALF + m * 16, sqv[ai][m]); }
        asm volatile("s_waitcnt vmcnt(0)" ::: "memory");
        unsigned* pc = pcnt + 64 * u.pm;
        if (fr == 0 && fq == 0) __hip_atomic_fetch_add(pc, 1u, __ATOMIC_RELAXED, __HIP_MEMORY_SCOPE_AGENT);
        { unsigned spins = 0; while ((unsigned)__builtin_amdgcn_readfirstlane((int)__hip_atomic_load(pc, __ATOMIC_RELAXED, __HIP_MEMORY_SCOPE_AGENT)) < 64u) { __builtin_amdgcn_s_sleep(2); if (++spins > (1u << 20)) break; } }
        float rsf[2][4];
#pragma unroll
        for (int ai = 0; ai < 2; ++ai)
#pragma unroll
            for (int m = 0; m < 4; ++m) rsf[ai][m] = rsqrtf(__hip_atomic_load(ssq + row0 + ai * HALF + m * 16, __ATOMIC_RELAXED, __HIP_MEMORY_SCOPE_AGENT) * (1.f / 2048.f) + 1e-6f);
#pragma unroll
        for (int bj = 0; bj < 2; ++bj) {
            const f32x4 g0 = *(const f32x4*)(gfin + col0 + bj * HALF), g1 = *(const f32x4*)(gfin + col0 + bj * HALF + 4);
#pragma unroll
            for (int ai = 0; ai < 2; ++ai)
#pragma unroll
                for (int m = 0; m < 4; ++m) { float* op = out + (size_t)(row0 + ai * HALF + m * 16) * 2048 + col0 + bj * HALF;
                    *(f32x4*)op = acc[ai][bj][m][0] * rsf[ai][m] * g0; *(f32x4*)(op + 4) = acc[ai][bj][m][1] * rsf[ai][m] * g1; } }
    }
};
struct EpiMoe1 {
    static constexpr bool PERM = true;
    unsigned char* HID; const float* rstd;
    DEV void operator()(Acc& acc, const Unit& u, int wr, int wc, int fr, int fq) const {
        const int col0 = u.pn * HALF + wc * 32 + 8 * fq;
        int aid[2][4];
#pragma unroll
        for (int ai = 0; ai < 2; ++ai)
#pragma unroll
            for (int m = 0; m < 4; ++m) { const int idx = ai * HALF + wr * 64 + m * 16 + fr; aid[ai][m] = u.rows[idx < u.mvalid ? idx : 0]; }
        float rsv[2][4];
#pragma unroll
        for (int ai = 0; ai < 2; ++ai)
#pragma unroll
            for (int m = 0; m < 4; ++m) rsv[ai][m] = rstd[aid[ai][m] >> 1];
#pragma unroll
        for (int ai = 0; ai < 2; ++ai)
#pragma unroll
            for (int m = 0; m < 4; ++m) { const int idx = ai * HALF + wr * 64 + m * 16 + fr;
                if (idx < u.mvalid) { f32x4 h0, h1; const float rs = rsv[ai][m] * (1.f / WGU_SCALE);
#pragma unroll
                    for (int j = 0; j < 4; ++j) { h0[j] = silu_f(rs * acc[ai][0][m][0][j]) * (rs * acc[ai][1][m][0][j]); h1[j] = silu_f(rs * acc[ai][0][m][1][j]) * (rs * acc[ai][1][m][1][j]); }
                    u32x2 q; q.x = pk4_fp8(clamp448(h0[0] * HID_SCALE), clamp448(h0[1] * HID_SCALE), clamp448(h0[2] * HID_SCALE), clamp448(h0[3] * HID_SCALE));
                    q.y = pk4_fp8(clamp448(h1[0] * HID_SCALE), clamp448(h1[1] * HID_SCALE), clamp448(h1[2] * HID_SCALE), clamp448(h1[3] * HID_SCALE));
                    __hip_atomic_store((unsigned long long*)(HID + (size_t)aid[ai][m] * 512 + col0), ((unsigned long long)q.y << 32) | q.x, __ATOMIC_RELAXED, __HIP_MEMORY_SCOPE_AGENT); } }
    }
};
struct EpiMoe2 {
    static constexpr bool PERM = true;
    unsigned char* Y; const float* ew;
    DEV void operator()(Acc& acc, const Unit& u, int wr, int wc, int fr, int fq) const {
        const int col0 = u.pn * BM + wc * 32 + 8 * fq;
        int aid[2][4]; float wv[2][4];
#pragma unroll
        for (int ai = 0; ai < 2; ++ai)
#pragma unroll
            for (int m = 0; m < 4; ++m) { const int idx = ai * HALF + wr * 64 + m * 16 + fr; aid[ai][m] = u.rows[idx < u.mvalid ? idx : 0]; }
#pragma unroll
        for (int ai = 0; ai < 2; ++ai)
#pragma unroll
            for (int m = 0; m < 4; ++m) wv[ai][m] = ew[aid[ai][m]] * (Y_SCALE / (HID_SCALE * WD_SCALE));
#pragma unroll
        for (int ai = 0; ai < 2; ++ai)
#pragma unroll
            for (int m = 0; m < 4; ++m) { const int idx = ai * HALF + wr * 64 + m * 16 + fr;
                if (idx < u.mvalid) {
#pragma unroll
                    for (int bj = 0; bj < 2; ++bj) { const f32x4 v0 = acc[ai][bj][m][0] * wv[ai][m], v1 = acc[ai][bj][m][1] * wv[ai][m];
                        u32x2 q; q.x = pk4_fp8(clamp448(v0[0]), clamp448(v0[1]), clamp448(v0[2]), clamp448(v0[3])); q.y = pk4_fp8(clamp448(v1[0]), clamp448(v1[1]), clamp448(v1[2]), clamp448(v1[3]));
                        *(u32x2*)(Y + (size_t)aid[ai][m] * 2048 + col0 + bj * HALF) = q; } } }
    }
};

struct SchedDense {
    unsigned lda, ldb; int nM, nN, G, c; int i0 = 0, iend = 1 << 30; int pn_off = 0;
    DEV bool next(int i, Unit& u) const { int pm, pn; if (i + i0 >= iend || !static_tile(i + i0, G, c, nM, nN, pm, pn)) return false;
        u.A = (unsigned)pm * BM * lda; u.B = (unsigned)pn * BM * ldb; u.rows = nullptr; u.pm = pm; u.pn = pn + pn_off; u.flags = 0; u.mvalid = BM; return true; }
    DEV void a_ready(const Unit&) const {} DEV void done(const Unit&) const {}
};
struct SchedDual {
    unsigned A1off, B1off; unsigned lda, ldb; int nM, nN, G, c;
    DEV bool next(int i, Unit& u) const { int pm, pn; if (!static_tile(i >> 1, G, c, nM, nN, pm, pn)) return false; const bool second = i & 1;
        u.A = (second ? A1off : 0u) + (unsigned)pm * BM * lda; u.B = (second ? B1off : 0u) + (unsigned)pn * BM * ldb; u.rows = nullptr; u.pm = pm; u.pn = pn; u.flags = second ? 0 : U_KEEP; u.mvalid = BM; return true; }
    DEV void a_ready(const Unit&) const {} DEV void done(const Unit&) const {}
};
struct SchedMoe {
    unsigned bestep; unsigned ldb; const int* list; const LAS int* pre; const LAS int* cl; int NT, G, c;
    unsigned* ready; int role, wave; int E = 0, SK = 0;
    DEV bool next(int i, Unit& u) const { const long L = (c < E) ? (long)SK * (G - E) + (long)i * G + c : (i < SK ? (long)i * (G - E) + (c - E) : (long)SK * (G - E) + (long)(i - SK) * G + c);
        const int total = __builtin_amdgcn_readfirstlane(pre[32]); if (L >= (long)total * NT) return false;
        const int rt = (int)(L / NT), pn = (int)(L % NT); int e = 0;
        for (int q = 1; q < 32; ++q) e += (pre[q] <= rt) ? 1 : 0;
        e = __builtin_amdgcn_readfirstlane(e);
        const int lt = rt - __builtin_amdgcn_readfirstlane(pre[e]); const int n = __builtin_amdgcn_readfirstlane(cl[e]);
        u.A = 0u; u.B = (unsigned)e * bestep + (unsigned)pn * BM * ldb; u.rows = list + e * CAP + lt * BM; u.pm = rt; u.pn = pn; u.flags = 0; u.mvalid = (n - lt * BM) < BM ? (n - lt * BM) : BM; return true; }
    DEV void a_ready(const Unit& u) const {
        if (role != 2) return;
        if (wave == 0) { unsigned* p = ready + 64 * u.pm; unsigned spins = 0;
            while ((unsigned)__builtin_amdgcn_readfirstlane((int)__hip_atomic_load(p, __ATOMIC_RELAXED, __HIP_MEMORY_SCOPE_AGENT)) < 32u) { __builtin_amdgcn_s_sleep(2); if (++spins > (1u << 20)) break; }
            __builtin_amdgcn_fence(__ATOMIC_ACQUIRE, "agent");
            asm volatile("s_waitcnt vmcnt(0)" ::: "memory"); }
        asm volatile("" ::: "memory"); __builtin_amdgcn_s_barrier(); asm volatile("" ::: "memory");
    }
    DEV void done(const Unit& u) const {
        if (role != 1) return;
        asm volatile("s_waitcnt vmcnt(0)" ::: "memory");
        if (__builtin_amdgcn_mbcnt_hi(~0u, __builtin_amdgcn_mbcnt_lo(~0u, 0u)) == 0u) __hip_atomic_fetch_add(ready + 64 * u.pm, 1u, __ATOMIC_RELAXED, __HIP_MEMORY_SCOPE_AGENT);
    }
};
struct SchedPanel {
    unsigned lda, ldb; int nM, G, v;
    DEV bool next(int i, Unit& u) const { const int pm = i * (G >> 3) + (v >> 3), pn = v & 7; if (pm >= nM) return false;
        u.A = (unsigned)pm * BM * lda; u.B = (unsigned)pn * BM * ldb; u.rows = nullptr; u.pm = pm; u.pn = pn; u.flags = 0; u.mvalid = BM; return true; }
    DEV void a_ready(const Unit&) const {} DEV void done(const Unit&) const {}
};
struct SchedOne { Unit u0; DEV bool next(int i, Unit& u) const { if (i != 0) return false; u = u0; return true; } DEV void a_ready(const Unit&) const {} DEV void done(const Unit&) const {} };
}

#define XB_TMO      128
#define XB_XCNT(j)  (256  + 64 * (j))
#define XB_XSUB(j)  (1280 + 64 * (j))
#define XB_XGEN(j)  (2304 + 64 * (j))
#define XB_TOP      3328
#define XB_TOPGEN   3392
#define XCD_BAR_WORDS 3456
#define XB_SPIN_CAP (1u << 18)
DEV unsigned xb_ld(unsigned* p)              { return __hip_atomic_load(p, __ATOMIC_RELAXED, __HIP_MEMORY_SCOPE_AGENT); }
DEV unsigned xb_add(unsigned* p, unsigned v) { return __hip_atomic_fetch_add(p, v, __ATOMIC_RELAXED, __HIP_MEMORY_SCOPE_AGENT); }
DEV unsigned xb_xcc_id() { return (unsigned)__builtin_amdgcn_s_getreg((3 << 11) | 20) & 0xFu; }
#define XB_SPIN(cond, bar) do { unsigned _sp = 0; while (cond) { __builtin_amdgcn_s_sleep(1); \
    if ((++_sp & 255u) == 0u) { if (xb_ld(&(bar)[XB_TMO])) break; if (_sp > XB_SPIN_CAP) { atomicAdd(&(bar)[XB_TMO], 1u); break; } } } } while (0)
struct XcdBarrier { unsigned* bar; unsigned x; volatile LAS unsigned* st; };
DEV XcdBarrier xcd_barrier_post(unsigned* bar, volatile LAS unsigned* st) {
    XcdBarrier b; b.bar = bar; b.x = xb_xcc_id(); b.st = st;
    if (threadIdx.x == 0) (void)xb_add(&bar[XB_XCNT(b.x)], 1u);
    return b;
}
DEV void xcd_barrier_complete(unsigned* bar, unsigned x, unsigned& nloc, unsigned& nx) {
    const unsigned G = gridDim.x * gridDim.y * gridDim.z;
    unsigned sum, cnt, mine, sp = 0u;
    for (;;) {
        sum = 0u; cnt = 0u; mine = 0u;
#pragma unroll
        for (unsigned j = 0; j < 16; ++j) { const unsigned c = xb_ld(&bar[XB_XCNT(j)]); sum += c; cnt += (c > 0u) ? 1u : 0u; mine = (j == x) ? c : mine; }
        if (sum == G) break;
        __builtin_amdgcn_s_sleep(1);
        if ((++sp & 255u) == 0u) { if (xb_ld(&bar[XB_TMO])) break; if (sp > XB_SPIN_CAP) { atomicAdd(&bar[XB_TMO], 1u); break; } }
    }
    nloc = mine > 0u ? mine : 1u; nx = cnt > 0u ? cnt : 1u;
}
DEV void xcd_barrier(const XcdBarrier& b, const int wave_s) {
    asm volatile("s_waitcnt vmcnt(0)" ::: "memory");
    __syncthreads();
    if (wave_s == 0 && __builtin_amdgcn_mbcnt_hi(~0u, __builtin_amdgcn_mbcnt_lo(~0u, 0u)) == 0u) {
        unsigned* bar = b.bar;
        __builtin_amdgcn_s_waitcnt(0);
        unsigned nloc = b.st[0], nx = b.st[1];
        if (nloc == 0u) { xcd_barrier_complete(bar, b.x, nloc, nx); b.st[0] = nloc; b.st[1] = nx; }
        const unsigned old = xb_add(&bar[XB_XSUB(b.x)], 1u);
        const unsigned gen = old / nloc;
        if (old + 1u == (gen + 1u) * nloc) {
            __builtin_amdgcn_fence(__ATOMIC_RELEASE, "agent");
            asm volatile("s_waitcnt vmcnt(0)" ::: "memory");
            const unsigned og = xb_add(&bar[XB_TOP], 1u);
            const unsigned tg = og / nx;
            if (og + 1u == (tg + 1u) * nx) xb_add(&bar[XB_TOPGEN], 1u);
            else XB_SPIN(xb_ld(&bar[XB_TOPGEN]) == tg, bar);
            __builtin_amdgcn_fence(__ATOMIC_ACQUIRE, "agent");
            xb_add(&bar[XB_XGEN(b.x)], 1u);
            asm volatile("s_waitcnt vmcnt(0)" ::: "memory");
        } else {
            XB_SPIN(xb_ld(&bar[XB_XGEN(b.x)]) == gen, bar);
            __builtin_amdgcn_fence(__ATOMIC_ACQUIRE, "agent");
            asm volatile("s_waitcnt vmcnt(0)" ::: "memory");
        }
    }
    __syncthreads();
}


#define LDS_WAIT() asm volatile("s_waitcnt lgkmcnt(0)" ::: "memory")
#define VM_WAIT() asm volatile("s_waitcnt vmcnt(0)" ::: "memory")
DEV float wave_sum(float v) {
#pragma unroll
    for (int o = 1; o < 64; o <<= 1) v += __shfl_xor(v, o);
    return v;
}
DEV unsigned pk2(float lo, float hi) { return pg8::cvt_pk_bf16(lo, hi); }
struct ItemD { const float* src; unsigned char* dst; const float* ks; int N, K; float cs; int q8; };
DEV bool item_try(int& r, ItemD& d, const float* W, int K, int N, int batch, long sstride, long dstride, void* WT, int mode, int row_off, const float* kscale, float cs, int q8, int ld = 0) {
    const int ik = q8 ? 128 : 64, in = q8 ? 32 : 64;
    const int nnb = N / in, per = (K / ik) * nnb, tot = per * batch;
    if (r >= tot) { r -= tot; return false; }
    const int b = r / per, q = r % per, k0 = (q / nnb) * ik, n0 = (q % nnb) * in;
    const int drow0 = mode == 0 ? row_off + n0 : 256 * (n0 >> 7) + (n0 & 127) + (mode == 2 ? 128 : 0);
    const int ldn = ld ? ld : N;
    d.src = W + (size_t)b * sstride + (size_t)k0 * ldn + n0; d.N = ldn; d.K = K; d.cs = cs; d.q8 = q8; d.ks = kscale ? kscale + k0 : nullptr;
    d.dst = (unsigned char*)WT + ((size_t)b * dstride + (size_t)drow0 * K + k0) * (q8 ? 1 : 2);
    return true;
}
DEV void item_load(const ItemD& d, f32x4 (&v)[16], f32x4 (&sc)[4], int lane) {
    const int kk = d.q8 ? lane >> 3 : lane >> 4, nq = d.q8 ? lane & 7 : lane & 15;
#pragma unroll
    for (int t = 0; t < 4; ++t) sc[t] = d.ks ? *(const f32x4*)(d.ks + 16 * kk + 4 * t) : (f32x4){1.f, 1.f, 1.f, 1.f};
    const float* p = d.src + (size_t)(16 * kk) * d.N + 4 * nq;
#pragma unroll
    for (int i = 0; i < 16; ++i) v[i] = __builtin_nontemporal_load((const f32x4*)(p + (size_t)i * d.N));
}
DEV void item_finish(const ItemD& d, const f32x4 (&v)[16], const f32x4 (&sc)[4], int lane) {
    const int kk = d.q8 ? lane >> 3 : lane >> 4, nq = d.q8 ? lane & 7 : lane & 15; const float cs = d.cs;
#pragma unroll
    for (int c = 0; c < 4; ++c) {
        float e[16];
#pragma unroll
        for (int i = 0; i < 16; ++i) e[i] = v[i][c] * (sc[i >> 2][i & 3] * cs);
        if (d.q8) { u32x4 o; o.x = pg8::pk4_fp8(e[0], e[1], e[2], e[3]); o.y = pg8::pk4_fp8(e[4], e[5], e[6], e[7]); o.z = pg8::pk4_fp8(e[8], e[9], e[10], e[11]); o.w = pg8::pk4_fp8(e[12], e[13], e[14], e[15]);
            *(u32x4*)(d.dst + (size_t)(4 * nq + c) * d.K + 16 * kk) = o; }
        else { u32x4 o0, o1; o0.x = pk2(e[0], e[1]); o0.y = pk2(e[2], e[3]); o0.z = pk2(e[4], e[5]); o0.w = pk2(e[6], e[7]); o1.x = pk2(e[8], e[9]); o1.y = pk2(e[10], e[11]); o1.z = pk2(e[12], e[13]); o1.w = pk2(e[14], e[15]);
            unsigned char* p = d.dst + ((size_t)(4 * nq + c) * d.K + 16 * kk) * 2; *(u32x4*)p = o0; *(u32x4*)(p + 16) = o1; } }
}
#define ITEM_STREAM(DEC, first, stride, count, lane) do { \
    ItemD dc_, dn_; f32x4 vc_[16], vn_[16], sc_[4], sn_[4]; int it_ = (first); \
    if (it_ < (count)) { DEC(it_, dc_); item_load(dc_, vc_, sc_, lane); \
        for (;;) { const int itn_ = it_ + (stride); const bool hn_ = itn_ < (count); \
            if (hn_) { DEC(itn_, dn_); item_load(dn_, vn_, sn_, lane); } \
            item_finish(dc_, vc_, sc_, lane); \
            if (!hn_) break; \
            dc_ = dn_; _Pragma("unroll") for (int q_ = 0; q_ < 16; ++q_) vc_[q_] = vn_[q_]; _Pragma("unroll") for (int q_ = 0; q_ < 4; ++q_) sc_[q_] = sn_[q_]; it_ = itn_; } } } while (0)
DEV void rms_row_q(const float* xrow, bf16_t* orow, unsigned char* oq, float* rstd_out, int lane) {
    f32x4 v[8]; float s = 0.f;
#pragma unroll
    for (int q = 0; q < 8; ++q) v[q] = *((const f32x4*)xrow + lane + 64 * q);
#pragma unroll
    for (int q = 0; q < 8; ++q) { s += (v[q][0] * v[q][0] + v[q][1] * v[q][1]) + (v[q][2] * v[q][2] + v[q][3] * v[q][3]);
        u32x2 o; o.x = pk2(v[q][0], v[q][1]); o.y = pk2(v[q][2], v[q][3]); *((u32x2*)orow + lane + 64 * q) = o;
        *((unsigned*)oq + lane + 64 * q) = pg8::pk4_fp8(v[q][0], v[q][1], v[q][2], v[q][3]); }
    s = wave_sum(s);
    if (lane == 0) *rstd_out = rsqrtf(s * (1.f / D) + EPS);
}
DEV void x2_row(const bf16_t* xrow, const unsigned char* y0, const unsigned char* y1, bf16_t* orow, unsigned char* oq, float* rstd_out, int lane) {
    u32x4 a[4]; u32x2 b[4], c[4];
#pragma unroll
    for (int j = 0; j < 4; ++j) { a[j] = *((const u32x4*)xrow + lane + 64 * j); b[j] = *((const u32x2*)y0 + lane + 64 * j); c[j] = *((const u32x2*)y1 + lane + 64 * j); }
    float s = 0.f;
#pragma unroll
    for (int j = 0; j < 4; ++j) { f32x4 v0, v1; pg8::unpack8(a[j], v0, v1);
        const f32x2 b0 = __builtin_amdgcn_cvt_pk_f32_fp8((int)b[j].x, false), b1 = __builtin_amdgcn_cvt_pk_f32_fp8((int)b[j].x, true), b2 = __builtin_amdgcn_cvt_pk_f32_fp8((int)b[j].y, false), b3 = __builtin_amdgcn_cvt_pk_f32_fp8((int)b[j].y, true);
        const f32x2 c0 = __builtin_amdgcn_cvt_pk_f32_fp8((int)c[j].x, false), c1 = __builtin_amdgcn_cvt_pk_f32_fp8((int)c[j].x, true), c2 = __builtin_amdgcn_cvt_pk_f32_fp8((int)c[j].y, false), c3 = __builtin_amdgcn_cvt_pk_f32_fp8((int)c[j].y, true);
        const float is = 1.f / Y_SCALE;
        v0[0] += (b0.x + c0.x) * is; v0[1] += (b0.y + c0.y) * is; v0[2] += (b1.x + c1.x) * is; v0[3] += (b1.y + c1.y) * is;
        v1[0] += (b2.x + c2.x) * is; v1[1] += (b2.y + c2.y) * is; v1[2] += (b3.x + c3.x) * is; v1[3] += (b3.y + c3.y) * is;
        s += ((v0[0] * v0[0] + v0[1] * v0[1]) + (v0[2] * v0[2] + v0[3] * v0[3])) + ((v1[0] * v1[0] + v1[1] * v1[1]) + (v1[2] * v1[2] + v1[3] * v1[3]));
        *((u32x4*)orow + lane + 64 * j) = pg8::pack8(v0, v1);
        u32x2 q; q.x = pg8::pk4_fp8(v0[0], v0[1], v0[2], v0[3]); q.y = pg8::pk4_fp8(v1[0], v1[1], v1[2], v1[3]); *((u32x2*)oq + lane + 64 * j) = q; }
    s = wave_sum(s);
    if (lane == 0) *rstd_out = rsqrtf(s * (1.f / D) + EPS);
}
DEV void zp_block(const bf16_t* AIN, bf16_t* ZP, int pm, int g, int tid) {
    const int c8 = tid & 31, run = tid >> 5, w = 2 << g;
    const int R0 = pm * 256 + run * 16, seq0 = R0 & ~(SEQ - 1), col = g * 256 + c8 * 8;
    u32x4 raw[31];
#pragma unroll
    for (int i = 0; i < 31; ++i) { const int R = R0 - 15 + i; raw[i] = *(const u32x4*)(AIN + (size_t)(R >= seq0 ? R : R0) * PW + col); }
    f32x4 s0 = (f32x4){0.f, 0.f, 0.f, 0.f}, s1 = s0;
#pragma unroll
    for (int i = 0; i < 15; ++i) { const int R = R0 - 15 + i; f32x4 a0, a1; pg8::unpack8(raw[i], a0, a1); const bool in = (15 - i) < w && R >= seq0; if (in) { s0 += a0; s1 += a1; } }
#pragma unroll
    for (int i = 0; i < 16; ++i) { const int R = R0 + i; f32x4 a0, a1; pg8::unpack8(raw[15 + i], a0, a1);
        s0 += a0; s1 += a1;
        const int tt = R - seq0; const float inv = 1.f / (float)((tt + 1 < w) ? tt + 1 : w);
        *(u32x4*)(ZP + (size_t)R * PW + col) = pg8::pack8(s0 * inv - a0, s1 * inv - a1);
        f32x4 b0, b1;
        if (w == 2) pg8::unpack8(raw[15 + i - 1], b0, b1); else if (w == 4) pg8::unpack8(raw[15 + i - 3], b0, b1); else if (w == 8) pg8::unpack8(raw[15 + i - 7], b0, b1); else pg8::unpack8(raw[i], b0, b1);
        if (R - w + 1 >= seq0) { s0 -= b0; s1 -= b1; } }
}
constexpr int VT_STRIDE = 272;
DEV void sgu_unit(LAS unsigned char* lds, const float* LNS, const bf16_t* GV, const bf16_t* UU, const bf16_t* WSb, const float* bsp, const float* lg, const float* lb, bf16_t* SB, int nb, int hf, int tid) {
    const int lane = tid & 63, wave = __builtin_amdgcn_readfirstlane(tid >> 6), fr = lane & 15, fq = lane >> 4;
    LAS float* st = (LAS float*)lds;
    LAS unsigned char* vt = lds + 2048;
    const int t0 = nb * 128;
    if (tid < 128) { float s1 = 0.f, s2 = 0.f; const f32x4* lp = (const f32x4*)(LNS + (size_t)(t0 + tid) * 32);
#pragma unroll
        for (int k = 0; k < 8; ++k) { const f32x4 q = lp[k]; s1 += q[0]; s2 += q[1]; s1 += q[2]; s2 += q[3]; }
        const float mean = s1 * (1.f / SW), var = __builtin_fmaxf(s2 * (1.f / SW) - mean * mean, 0.f);
        st[2 * tid] = mean; st[2 * tid + 1] = rsqrtf(var + EPS); }
    __syncthreads();
    const int half = wave >> 2, wv = wave & 3, th = tid & 255;
    LAS unsigned char* vb = vt + half * (128 * VT_STRIDE);
    for (int rd = 0; rd < 2; ++rd) { const int g = hf * 4 + rd * 2 + half;
        const int s4 = th & 31, c8a = th >> 5;
        f32x4 lgv[2][2], lbv[2][2]; u32x4 gvr[2][4];
#pragma unroll
        for (int h = 0; h < 2; ++h) { const int cg = g * 128 + (c8a + 8 * h) * 8; lgv[h][0] = *(const f32x4*)(lg + cg); lgv[h][1] = *(const f32x4*)(lg + cg + 4); lbv[h][0] = *(const f32x4*)(lb + cg); lbv[h][1] = *(const f32x4*)(lb + cg + 4); }
#pragma unroll
        for (int h = 0; h < 2; ++h)
#pragma unroll
            for (int i = 0; i < 4; ++i) gvr[h][i] = *(const u32x4*)(GV + (size_t)(t0 + 4 * s4 + i) * SW + g * 128 + (c8a + 8 * h) * 8);
        bf16x8 wf[2][4]; u32x2 uws[2][8]; float bias[2];
#pragma unroll
        for (int tb = 0; tb < 2; ++tb)
#pragma unroll
            for (int kk = 0; kk < 4; ++kk) wf[tb][kk] = *(const bf16x8*)(WSb + (size_t)(g * 128 + (wv + 4 * tb) * 16 + fr) * 128 + kk * 32 + fq * 8);
#pragma unroll
        for (int tb = 0; tb < 2; ++tb) { bias[tb] = bsp[g * 128 + (wv + 4 * tb) * 16 + fr];
#pragma unroll
            for (int cb = 0; cb < 8; ++cb) uws[tb][cb] = *(const u32x2*)(UU + (size_t)(t0 + (wv + 4 * tb) * 16 + fr) * SW + g * 128 + cb * 16 + fq * 4); }
        if (rd) __syncthreads();
#pragma unroll
        for (int h = 0; h < 2; ++h) { const int c8 = c8a + 8 * h; f32x4 v0[4], v1[4];
#pragma unroll
            for (int i = 0; i < 4; ++i) { const int r = 4 * s4 + i; pg8::unpack8(gvr[h][i], v0[i], v1[i]);
                const float mean = st[2 * r], rstd = st[2 * r + 1]; v0[i] = (v0[i] - mean) * rstd * lgv[h][0] + lbv[h][0]; v1[i] = (v1[i] - mean) * rstd * lgv[h][1] + lbv[h][1]; }
#pragma unroll
            for (int q = 0; q < 4; ++q) { u32x2 o; o.x = pk2(v0[0][q], v0[1][q]); o.y = pk2(v0[2][q], v0[3][q]); *(LAS u32x2*)(vb + (c8 * 8 + q) * VT_STRIDE + s4 * 8) = o;
                u32x2 o2; o2.x = pk2(v1[0][q], v1[1][q]); o2.y = pk2(v1[2][q], v1[3][q]); *(LAS u32x2*)(vb + (c8 * 8 + 4 + q) * VT_STRIDE + s4 * 8) = o2; } }
        __syncthreads();
        f32x4 acc[2][8];
#pragma unroll
        for (int tb = 0; tb < 2; ++tb)
#pragma unroll
            for (int cb = 0; cb < 8; ++cb) acc[tb][cb] = (f32x4){0.f, 0.f, 0.f, 0.f};
#pragma unroll
        for (int cb = 0; cb < 8; ++cb)
#pragma unroll
            for (int kk = 0; kk < 4; ++kk) { const bf16x8 af = *(const LAS bf16x8*)(vb + (cb * 16 + fr) * VT_STRIDE + (kk * 32 + fq * 8) * 2);
                acc[0][cb] = __builtin_amdgcn_mfma_f32_16x16x32_bf16(af, wf[0][kk], acc[0][cb], 0, 0, 0);
                acc[1][cb] = __builtin_amdgcn_mfma_f32_16x16x32_bf16(af, wf[1][kk], acc[1][cb], 0, 0, 0); }
#pragma unroll
        for (int tb = 0; tb < 2; ++tb) { const int tg = t0 + (wv + 4 * tb) * 16 + fr;
#pragma unroll
            for (int cb = 0; cb < 8; ++cb) { const size_t off = (size_t)tg * SW + g * 128 + cb * 16 + fq * 4; const u32x2 uw = uws[tb][cb];
                u32x2 o; o.x = pk2(__uint_as_float(uw.x << 16) * (acc[tb][cb][0] + bias[tb]), __uint_as_float(uw.x & 0xffff0000u) * (acc[tb][cb][1] + bias[tb]));
                o.y = pk2(__uint_as_float(uw.y << 16) * (acc[tb][cb][2] + bias[tb]), __uint_as_float(uw.y & 0xffff0000u) * (acc[tb][cb][3] + bias[tb]));
                *(u32x2*)(SB + off) = o; } }
    }
    __syncthreads();
}

constexpr int RP_STRIDE = 52;
DEV void split8(const f32x4 a0, const f32x4 a1, bf16x8& hi, bf16x8& lo) {
    u32x4 h; h.x = pk2(a0[0], a0[1]); h.y = pk2(a0[2], a0[3]); h.z = pk2(a1[0], a1[1]); h.w = pk2(a1[2], a1[3]);
    f32x4 r0, r1; pg8::unpack8(h, r0, r1); r0 = a0 - r0; r1 = a1 - r1;
    u32x4 l; l.x = pk2(r0[0], r0[1]); l.y = pk2(r0[2], r0[3]); l.z = pk2(r1[0], r1[1]); l.w = pk2(r1[2], r1[3]);
    hi = __builtin_bit_cast(bf16x8, h); lo = __builtin_bit_cast(bf16x8, l);
}
DEV void router_group(LAS unsigned char* lds, const bf16_t* x1, const bf16_t* WRh, const bf16_t* WRl, const float* b_rg, const float* b_re,
                      float* ew, float* rstd_out, int* cnt, int* list, int grp, int tid) {
    const int lane = tid & 63, wave = __builtin_amdgcn_readfirstlane(tid >> 6), fr = lane & 15, fq = lane >> 4;
    LAS float* part = (LAS float*)lds;
    LAS float* ssb = (LAS float*)(lds + 8 * 64 * RP_STRIDE * 4);
    LAS int* hist = (LAS int*)(lds + 8 * 64 * RP_STRIDE * 4 + 2048);
    LAS int* base = hist + 32;
    const int row0 = grp * 64;
    if (tid < 32) hist[tid] = 0;
    f32x4 acc[4][3]; float ssp[4];
#pragma unroll
    for (int rb = 0; rb < 4; ++rb) { ssp[rb] = 0.f;
#pragma unroll
        for (int nb = 0; nb < 3; ++nb) acc[rb][nb] = (f32x4){0.f, 0.f, 0.f, 0.f}; }
#pragma unroll 4
    for (int ks = 0; ks < 8; ++ks) { const int k0 = wave * 256 + ks * 32 + fq * 8;
        bf16x8 bh[3], bl[3];
#pragma unroll
        for (int nb = 0; nb < 3; ++nb) { bh[nb] = *(const bf16x8*)(WRh + (size_t)(nb * 16 + fr) * D + k0); bl[nb] = *(const bf16x8*)(WRl + (size_t)(nb * 16 + fr) * D + k0); }
        u32x4 xa[4];
#pragma unroll
        for (int rb = 0; rb < 4; ++rb) xa[rb] = *(const u32x4*)(x1 + (size_t)(row0 + rb * 16 + fr) * D + k0);
#pragma unroll
        for (int rb = 0; rb < 4; ++rb) { f32x4 a0, a1; pg8::unpack8(xa[rb], a0, a1);
            ssp[rb] += ((a0[0] * a0[0] + a0[1] * a0[1]) + (a0[2] * a0[2] + a0[3] * a0[3])) + ((a1[0] * a1[0] + a1[1] * a1[1]) + (a1[2] * a1[2] + a1[3] * a1[3]));
            const bf16x8 ah = __builtin_bit_cast(bf16x8, xa[rb]);
#pragma unroll
            for (int nb = 0; nb < 3; ++nb) { acc[rb][nb] = __builtin_amdgcn_mfma_f32_16x16x32_bf16(ah, bh[nb], acc[rb][nb], 0, 0, 0);
                acc[rb][nb] = __builtin_amdgcn_mfma_f32_16x16x32_bf16(ah, bl[nb], acc[rb][nb], 0, 0, 0); } }
    }
    LAS float* pw = part + wave * 64 * RP_STRIDE;
#pragma unroll
    for (int rb = 0; rb < 4; ++rb) { float v = ssp[rb]; v += __shfl_xor(v, 16); v += __shfl_xor(v, 32); if (fq == 0) ssb[wave * 64 + rb * 16 + fr] = v;
#pragma unroll
        for (int nb = 0; nb < 3; ++nb)
#pragma unroll
            for (int q = 0; q < 4; ++q) pw[(rb * 16 + 4 * fq + q) * RP_STRIDE + nb * 16 + fr] = acc[rb][nb][q]; }
    __syncthreads();
    int e0 = 0, e1 = 0, lr0 = 0, lr1 = 0; float w0 = 0.f, w1 = 0.f;
    if (tid < 64) { const int r = tid;
        float ss = 0.f;
#pragma unroll
        for (int w = 0; w < 8; ++w) ss += ssb[w * 64 + r];
        const float rstd = rsqrtf(ss * (1.f / D) + EPS);
        rstd_out[row0 + r] = rstd;
        float gl[4];
#pragma unroll
        for (int o = 0; o < 4; ++o) { float sacc = 0.f;
#pragma unroll
            for (int w = 0; w < 8; ++w) sacc += part[(w * 64 + r) * RP_STRIDE + o];
            gl[o] = sacc * rstd + b_rg[o]; }
        float best = gl[0]; int gi = 0;
#pragma unroll
        for (int o = 1; o < 4; ++o) if (gl[o] > best) { best = gl[o]; gi = o; }
        float se = 0.f;
#pragma unroll
        for (int o = 0; o < 4; ++o) se += __expf(gl[o] - best);
        const float gp = 1.f / se;
        float l0 = -3.0e38f, l1 = -3.0e38f; int i0 = 0, i1 = 0;
        for (int o = 0; o < 8; ++o) { float sacc = 0.f;
#pragma unroll
            for (int w = 0; w < 8; ++w) sacc += part[(w * 64 + r) * RP_STRIDE + 4 + gi * 8 + o];
            const float sv = sacc * rstd + b_re[gi * 8 + o];
            if (sv > l0) { l1 = l0; i1 = i0; l0 = sv; i0 = o; } else if (sv > l1) { l1 = sv; i1 = o; } }
        const float e = __expf(l1 - l0);
        w0 = gp / (1.f + e); w1 = gp * e / (1.f + e); e0 = gi * 8 + i0; e1 = gi * 8 + i1;
        lr0 = atomicAdd((int*)(hist + e0), 1); lr1 = atomicAdd((int*)(hist + e1), 1);
    }
    __syncthreads();
    if (tid < 32) { const int n = hist[tid]; base[tid] = n ? atomicAdd(cnt + tid, n) : 0; }
    __syncthreads();
    if (tid < 64) { const int t = row0 + tid; ew[2 * t] = w0; ew[2 * t + 1] = w1;
        list[e0 * CAP + base[e0] + lr0] = 2 * t; list[e1 * CAP + base[e1] + lr1] = 2 * t + 1; }
    __syncthreads();
}

constexpr int NWAVES = 8;
constexpr int RING_OFF = 0, RING_BYTES = 131072;
constexpr int LDSCTL_OFF = RING_BYTES, MISC_OFF = LDSCTL_OFF + 320;
constexpr int LDS_BYTES = 147456;
constexpr int CW_BAR = 4096;
constexpr size_t WS_PU = 550 * MiB;
constexpr size_t WS_END2 = 614 * MiB;
constexpr int N_PHASES = 10;

struct Args { const float* in[28]; float* out; unsigned char* ws; int ph_lo, ph_hi, li, pad; };

DEV void moe_tables(LAS int* pre, LAS int* cl, const int* cnt, int tid) {
    if (tid == 0) { int a = 0; for (int e = 0; e < 32; ++e) { const int n = cnt[e]; cl[e] = n; pre[e] = a; a += (n + 255) >> 8; } pre[32] = a; }
    __syncthreads();
}

__global__ void __launch_bounds__(NWAVES * 64, 2) mk_fwd(Args args) {
    extern __shared__ __attribute__((aligned(16))) unsigned char lds_raw[];
    LAS unsigned char* lds = (LAS unsigned char*)lds_raw;
    volatile LAS unsigned* MISC = (volatile LAS unsigned*)(lds + MISC_OFF);
    const int G = gridDim.x; const int bx = blockIdx.x;
    const int wave_s = __builtin_amdgcn_readfirstlane(threadIdx.x >> 6);
    for (int u = threadIdx.x; u < (LDS_BYTES - LDSCTL_OFF) / 4; u += NWAVES * 64) ((LAS unsigned*)(lds + LDSCTL_OFF))[u] = 0u;
    __syncthreads();
    const int lo = args.ph_lo, hi = args.ph_hi;
    XcdBarrier bar; bar.bar = (unsigned*)(args.ws + WS_CTL) + CW_BAR + args.li * XCD_BAR_WORDS; bar.x = 0; bar.st = nullptr;
    if (hi - lo > 1) bar = xcd_barrier_post((unsigned*)(args.ws + WS_CTL) + CW_BAR + args.li * XCD_BAR_WORDS, MISC + 8);
#ifndef PH_EN
#define PH_EN 0x3FF
#endif
#ifndef REPEAT_PH
#define REPEAT_PH -1
#endif
#define IN(k) (((PH_EN >> (k)) & 1) && lo <= (k) && (k) < hi)
#ifndef SEAM_REPS
#define SEAM_REPS 1
#endif
#define SEAM(k) do { if (IN(k) && IN((k) + 1)) { for (int sr_ = 0; sr_ < SEAM_REPS; ++sr_) xcd_barrier(bar, wave_s); } } while (0)
#define REPS(k) (((k) == REPEAT_PH) ? 2 : 1)
#define PHASE_BEGIN \
    int tid; asm volatile("v_mbcnt_lo_u32_b32 %0, -1, 0\n\tv_mbcnt_hi_u32_b32 %0, -1, %0" : "=v"(tid)); tid += wave_s * 64; \
    const __attribute__((address_space(4))) Args* ap = (const __attribute__((address_space(4))) Args*)__builtin_amdgcn_kernarg_segment_ptr(); asm volatile("" : "+s"(ap)); \
    unsigned char* ws = ap->ws; float* out = ap->out; \
    const int lane = tid & 63, wave = __builtin_amdgcn_readfirstlane(tid >> 6); \
    const int vcu = (G % 8 == 0) ? (bx % 8) * (G / 8) + bx / 8 : bx; const int gw = vcu * NWAVES + wave, NGW = G * NWAVES; \
    (void)lane; (void)wave; (void)gw; (void)NGW; (void)ws; (void)out;
#define WSP(T_, off) ((T_*)(ws + (off)))
    LAS int* pre = (LAS int*)(lds + LDSCTL_OFF + 1024); LAS int* cl = pre + 64;

    for (int rep_ = 0; rep_ < REPS(0); ++rep_) { if (rep_) xcd_barrier(bar, wave_s);
    if (IN(0)) { PHASE_BEGIN
        bf16_t* W1t = WSP(bf16_t, WS_W1T);
        constexpr int NITEMS = (D / 64) * (NIN / 64) + (D / 64) * (2 * D / 64) + 2 * (PW / 64) * (D / 64) + 2 * (D / 64) * (D / 64) + (PLE / 64) * (D / 64);
#define DEC_P0(r_in, d) do { int r = (r_in); \
            if (item_try(r, d, ap->in[3], D, PW, 1, 0, 0, W1t, 0, 0, ap->in[2], 1.f, 0, NIN)) break;     \
            if (item_try(r, d, ap->in[3] + PW, D, 2 * SW, 1, 0, 0, WSP(bf16_t, WS_WMGQ), 0, 0, ap->in[2], WGU_SCALE, 1, NIN)) break;     \
            if (item_try(r, d, ap->in[12], D, 2 * D, 1, 0, 0, WSP(bf16_t, WS_WMGQ), 0, 2 * SW, ap->in[2], WGU_SCALE, 1)) break;     \
            if (item_try(r, d, ap->in[6], PW, D, 1, 0, 0, WSP(bf16_t, WS_WAT), 0, 0, nullptr, 1.f, 0)) break; \
            if (item_try(r, d, ap->in[11], SW, D, 1, 0, 0, WSP(bf16_t, WS_WBT), 0, 0, nullptr, 1.f, 0)) break; \
            if (item_try(r, d, ap->in[14], D, D, 1, 0, 0, WSP(bf16_t, WS_WOT), 0, 0, nullptr, 1.f, 0)) break; \
            if (item_try(r, d, ap->in[24], D, D, 1, 0, 0, WSP(bf16_t, WS_WPGT), 0, 0, ap->in[23], WGU_SCALE, 1)) break;     \
            item_try(r, d, ap->in[26], PLE, D, 1, 0, 0, WSP(bf16_t, WS_WPUT), 0, 0, nullptr, 1.f, 0); } while (0)
        { const int ch = (NITEMS + NGW - 1) / NGW, lo_ = gw * ch, hi_ = (lo_ + ch) < NITEMS ? (lo_ + ch) : NITEMS;
          ITEM_STREAM(DEC_P0, lo_, 1, hi_, lane); }
#undef DEC_P0
        { const float *wp = ap->in[4], *ps = ap->in[5]; bf16_t* WPS = WSP(bf16_t, WS_WPS); for (int i = bx * 512 + tid; i < 4 * 256 * 256; i += G * 512) WPS[i] = f2bf(wp[i] * ps[(i >> 16) * 256 + (i & 255)]); }
        { const float* wsp = ap->in[9]; bf16_t* WSb = WSP(bf16_t, WS_WSB); for (int i = bx * 512 + tid; i < 8 * 128 * 128; i += G * 512) { const int sidx = i & 127, t = (i >> 7) & 127; WSb[i] = f2bf(((sidx >> 6) <= (t >> 6)) ? wsp[i] : 0.f); } }
        { const float *wrg = ap->in[16], *wre = ap->in[18], *gf = ap->in[15]; bf16_t *WRh = WSP(bf16_t, WS_WRH), *WRl = WSP(bf16_t, WS_WRL);
          for (int i = bx * 512 + tid; i < 48 * D; i += G * 512) { const int o = i / D, k = i % D; float w = 0.f;
              if (o < 4) w = wrg[k * 4 + o]; else if (o < 36) w = wre[((size_t)((o - 4) >> 3) * D + k) * 8 + ((o - 4) & 7)];
              w *= gf[k]; const bf16_t h = f2bf(w); WRh[i] = h; WRl[i] = f2bf(w - bf2f(h)); } }
        { const float* pin = ap->in[1]; bf16_t* PB = WSP(bf16_t, WS_PB); for (long i = (long)(bx * 512 + tid) * 4; i < (long)T * PLE; i += (long)G * 512 * 4) { const f32x4 v = *(const f32x4*)(pin + i); u32x2 o; o.x = pk2(v[0], v[1]); o.y = pk2(v[2], v[3]); *(u32x2*)(PB + i) = o; } }
        { const float* x = ap->in[0]; bf16_t* XN = WSP(bf16_t, WS_XN); unsigned char* XNQ = WSP(unsigned char, WS_XNQ); float* rs0 = WSP(float, WS_RSTD0);
          for (int m = gw; m < T; m += NGW) rms_row_q(x + (size_t)m * D, XN + (size_t)m * D, XNQ + (size_t)m * D, rs0 + m, lane); }
    }
    }
    SEAM(0);
    for (int rep_ = 0; rep_ < REPS(1); ++rep_) { if (rep_) xcd_barrier(bar, wave_s);
    if (IN(1)) {
        const int p = (bx >> 3) & 7;
#define P1_Z(i0_, i1_) { PHASE_BEGIN \
          pg8::SchedDense S{D * 2u, D * 2u, T / 256, PW / 256, G, bx, (i0_), (i1_)}; \
          pg8::EpiP1 E{WSP(bf16_t, WS_AIN), WSP(bf16_t, WS_UU), WSP(bf16_t, WS_GV), WSP(bf16_t, WS_GATES), ap->in[13], 1.f, WSP(float, WS_RSTD0), WSP(float, WS_LNS)}; \
          pg8::gemm_phase<pg8::EpiP1, pg8::SchedDense, true, false>(lds + RING_OFF, WSP(const char, WS_XN), WSP(const char, WS_W1T), D * 2u, D * 2u, D / 64, 0, S, E, tid); }
#define P1_G(i0_, i1_) { PHASE_BEGIN \
          pg8::SchedDense S{(unsigned)D, (unsigned)D, T / 256, (2 * SW + 2 * D) / 256, G, bx, (i0_), (i1_), PW / 256}; \
          pg8::EpiP1 E{WSP(bf16_t, WS_AIN), WSP(bf16_t, WS_UU), WSP(bf16_t, WS_GV), WSP(bf16_t, WS_GATES), ap->in[13], 1.f / WGU_SCALE, WSP(float, WS_RSTD0), WSP(float, WS_LNS)}; \
          pg8::gemm_phase<pg8::EpiP1, pg8::SchedDense, true, false, true>(lds + RING_OFF, WSP(const char, WS_XNQ), WSP(const char, WS_WMGQ), (unsigned)D, (unsigned)D, D / 128, 0, S, E, tid); }
#define P1_SLOT() { PHASE_BEGIN \
          constexpr int NX = 2 * NE * (D / 64) * (DE / 64) + NE * (DE / 64) * (D / 64);     \
          const int ch = (NX + NGW - 1) / NGW, lo_ = gw * ch, hi_ = (lo_ + ch) < NX ? (lo_ + ch) : NX;     \
          ITEM_STREAM(DEC_X, lo_, 1, hi_, lane); \
          VM_WAIT(); __syncthreads(); }
#define DEC_X(r_in, d) do { int r = (r_in); \
          if (item_try(r, d, ap->in[20], D, DE, NE, (long)D * DE, (long)1024 * D, WSP(bf16_t, WS_WGUT), 1, 0, ap->in[15], WGU_SCALE, 1)) break;     \
          if (item_try(r, d, ap->in[21], D, DE, NE, (long)D * DE, (long)1024 * D, WSP(bf16_t, WS_WGUT), 2, 0, ap->in[15], WGU_SCALE, 1)) break; \
          item_try(r, d, ap->in[22], DE, D, NE, (long)DE * D, (long)D * DE, WSP(bf16_t, WS_WDT), 0, 0, nullptr, WD_SCALE, 1); } while (0)
        if (bx < 32) { PHASE_BEGIN
          const int g = bx >> 3, pm = bx & 7;
          pg8::SchedOne S; S.u0.A = (unsigned)(((size_t)pm * 256 * PW + g * 256) * 2); S.u0.B = (unsigned)g * 65536u * 2u; S.u0.rows = nullptr; S.u0.pm = pm; S.u0.pn = g; S.u0.flags = 0; S.u0.mvalid = 256;
          pg8::EpiBf16S E{WSP(bf16_t, WS_W2T), PW, nullptr};
          pg8::gemm_phase<pg8::EpiBf16S, pg8::SchedOne, true, false>(lds + RING_OFF, WSP(const char, WS_WAT), WSP(const char, WS_WPS), PW * 2u, 256 * 2u, 4, 0, S, E, tid); }
        if (p == 0) { P1_SLOT() P1_Z(0, 1 << 30) P1_G(0, 1 << 30) }
        else { P1_Z(0, 1 << 30) P1_G(0, p - 1) P1_SLOT() P1_G(p - 1, 1 << 30) }
#undef P1_Z
#undef P1_G
#undef P1_SLOT
#undef DEC_X
    }
    }
    SEAM(1);
    for (int rep_ = 0; rep_ < REPS(2); ++rep_) { if (rep_) xcd_barrier(bar, wave_s);
    if (IN(2)) {
        for (int L = bx; L < (T / 256) * 4; L += G) { PHASE_BEGIN
            const int pm = L >> 2, g = L & 3;
            bf16_t* ZP = (bf16_t*)out;
            zp_block(WSP(bf16_t, WS_AIN), ZP, pm, g, tid); }
        for (int L = bx; L < (T / 128) * 2; L += G) { PHASE_BEGIN
            bf16_t* SB = (bf16_t*)out + (size_t)2 * T * PW;
            sgu_unit(lds + RING_OFF, WSP(float, WS_LNS), WSP(bf16_t, WS_GV), WSP(bf16_t, WS_UU), WSP(bf16_t, WS_WSB), ap->in[10], ap->in[7], ap->in[8], SB, L >> 1, L & 1, tid); }
    }
    }
    SEAM(2);
    for (int rep_ = 0; rep_ < REPS(3); ++rep_) { if (rep_) xcd_barrier(bar, wave_s);
    if (IN(3)) {
        { PHASE_BEGIN
          const char* ZPc = (const char*)out;
          pg8::SchedDual S{(unsigned)((size_t)2 * T * PW * 2), (unsigned)(WS_WBT - WS_W2T), PW * 2u, PW * 2u, T / 256, D / 256, G, bx};
          pg8::EpiMerge E{WSP(bf16_t, WS_GATES), WSP(bf16_t, WS_MG)};
          pg8::gemm_phase<pg8::EpiMerge, pg8::SchedDual, true, false>(lds + RING_OFF, ZPc, WSP(const char, WS_W2T), PW * 2u, PW * 2u, PW / 64, 0, S, E, tid); }
        { PHASE_BEGIN
          pg8::SchedDense S{PLE * 2u, PLE * 2u, T / 256, D / 256, G, bx};
          pg8::EpiBf16S E{WSP(bf16_t, WS_PU), D, nullptr};
          pg8::gemm_phase<pg8::EpiBf16S, pg8::SchedDense, true, false>(lds + RING_OFF, WSP(const char, WS_PB), WSP(const char, WS_WPUT), PLE * 2u, PLE * 2u, PLE / 64, 0, S, E, tid); }
    }
    }
    SEAM(3);
    for (int rep_ = 0; rep_ < REPS(4); ++rep_) { if (rep_) xcd_barrier(bar, wave_s);
    if (IN(4)) { PHASE_BEGIN
        pg8::SchedDense S{D * 2u, D * 2u, T / 256, D / 256, G, bx};
        pg8::EpiResBf16 E{WSP(bf16_t, WS_XN), (unsigned char*)out};
        pg8::gemm_phase<pg8::EpiResBf16, pg8::SchedDense, true, false>(lds + RING_OFF, WSP(const char, WS_MG), WSP(const char, WS_WOT), D * 2u, D * 2u, D / 64, 0, S, E, tid);
    }
    }
    SEAM(4);
    if (IN(5)) {
        for (int grp = bx; grp < T / 64; grp += G) { PHASE_BEGIN
            router_group(lds + RING_OFF, WSP(bf16_t, WS_XN), WSP(bf16_t, WS_WRH), WSP(bf16_t, WS_WRL), ap->in[17], ap->in[19], WSP(float, WS_EW), WSP(float, WS_RSTD), WSP(int, WS_CTL), WSP(int, WS_LIST), grp, tid); }
    }
    SEAM(5);
    for (int rep_ = 0; rep_ < REPS(6); ++rep_) { if (rep_) xcd_barrier(bar, wave_s);
    if (IN(6)) { PHASE_BEGIN
        moe_tables(pre, cl, WSP(int, WS_CTL), tid);
        pg8::SchedMoe S{1024u * D, (unsigned)D, WSP(int, WS_LIST), pre, cl, 4, G, vcu, WSP(unsigned, WS_MOERDY), 1, wave};
        pg8::EpiMoe1 E{WSP(unsigned char, WS_HID), WSP(float, WS_RSTD)};
        pg8::gemm_phase<pg8::EpiMoe1, pg8::SchedMoe, true, true, true>(lds + RING_OFF, out, WSP(const char, WS_WGUT), (unsigned)D, (unsigned)D, D / 128, 1, S, E, tid);
    }
    }
    for (int rep_ = 0; rep_ < REPS(7); ++rep_) { if (rep_) xcd_barrier(bar, wave_s);
    if (IN(7)) { PHASE_BEGIN
        moe_tables(pre, cl, WSP(int, WS_CTL), tid);
        const int r1 = (__builtin_amdgcn_readfirstlane(pre[32]) * 4) % G;
        pg8::SchedMoe S{(unsigned)D * DE, (unsigned)DE, WSP(int, WS_LIST), pre, cl, 8, G, vcu, WSP(unsigned, WS_MOERDY), 2, wave, r1, 2};
        pg8::EpiMoe2 E{WSP(unsigned char, WS_Y), WSP(float, WS_EW)};
        pg8::gemm_phase<pg8::EpiMoe2, pg8::SchedMoe, true, true, true>(lds + RING_OFF, WSP(const char, WS_HID), WSP(const char, WS_WDT), (unsigned)DE, (unsigned)DE, DE / 128, 0, S, E, tid);
    }
    }
    SEAM(7);
    if (IN(8)) { PHASE_BEGIN
        const unsigned char* Y = WSP(unsigned char, WS_Y); bf16_t *XB = WSP(bf16_t, WS_XN), *X2 = WSP(bf16_t, WS_X2B); unsigned char* X2Q = WSP(unsigned char, WS_X2Q); float* rs2 = WSP(float, WS_RSTD2);
        for (int m = gw; m < T; m += NGW) x2_row(XB + (size_t)m * D, Y + (size_t)(2 * m) * D, Y + (size_t)(2 * m + 1) * D, X2 + (size_t)m * D, X2Q + (size_t)m * D, rs2 + m, lane);
    }
    SEAM(8);
    if (IN(9)) { PHASE_BEGIN
        pg8::SchedPanel S{(unsigned)D, (unsigned)D, T / 256, G, vcu};
        pg8::EpiPleFinal E{WSP(bf16_t, WS_X2B), WSP(float, WS_RSTD2), ap->in[25], WSP(bf16_t, WS_PU), ap->in[27], out, WSP(float, WS_SSQ), WSP(unsigned, WS_PCNT)};
        pg8::gemm_phase<pg8::EpiPleFinal, pg8::SchedPanel, true, false, true>(lds + RING_OFF, WSP(const char, WS_X2Q), WSP(const char, WS_WPGT), (unsigned)D, (unsigned)D, D / 128, 0, S, E, tid);
    }
#undef IN
#undef SEAM
}


static int g_grid = 0;
extern "C" void kernel_launch(void* const* d_in, const int* in_sizes, int n_in, void* d_out, int out_size, void* d_ws, size_t ws_size, hipStream_t stream) {
    if (g_grid == 0) {
        if (n_in != 28 || in_sizes[0] != T * D || out_size != T * D || ws_size < WS_END2) { fprintf(stderr, "kernel_launch: unexpected shapes (n_in %d, in0 %d, out %d, ws %zu)\n", n_in, n_in > 0 ? in_sizes[0] : -1, out_size, ws_size); g_grid = -1; return; }
        int dev = 0, cus = 0, per_cu = 0;
        if (hipGetDevice(&dev) != hipSuccess || hipDeviceGetAttribute(&cus, hipDeviceAttributeMultiprocessorCount, dev) != hipSuccess) { fprintf(stderr, "kernel_launch: device query failed\n"); g_grid = -1; return; }
        if (hipFuncSetAttribute((const void*)mk_fwd, hipFuncAttributeMaxDynamicSharedMemorySize, LDS_BYTES) != hipSuccess) { fprintf(stderr, "kernel_launch: hipFuncSetAttribute failed\n"); g_grid = -1; return; }
        if (hipOccupancyMaxActiveBlocksPerMultiprocessor(&per_cu, (const void*)mk_fwd, NWAVES * 64, LDS_BYTES) != hipSuccess || per_cu < 1) { fprintf(stderr, "kernel_launch: occupancy query says %d workgroups per CU\n", per_cu); g_grid = -1; return; }
        g_grid = cus & ~7;
        if (g_grid < 8) { fprintf(stderr, "kernel_launch: %d CUs?\n", cus); g_grid = -1; return; }
    }
    if (g_grid < 0) return;
    (void)hipMemsetAsync((unsigned char*)d_ws + WS_CTL, 0, 1 * MiB, stream);
    Args a{};
    for (int i = 0; i < 28; ++i) a.in[i] = (const float*)d_in[i];
    a.out = (float*)d_out; a.ws = (unsigned char*)d_ws; a.ph_lo = 0; a.ph_hi = N_PHASES; a.li = 0; a.pad = 0;
#ifndef SPLIT_REPEAT
#define SPLIT_REPEAT 1
#endif
#ifdef SPLIT_AT
    a.ph_hi = SPLIT_AT + SPLIT_REPEAT;
    hipLaunchKernelGGL(mk_fwd, dim3(g_grid), dim3(NWAVES * 64), LDS_BYTES, stream, a);
    a.ph_lo = SPLIT_AT; a.ph_hi = N_PHASES; a.li = 1;
    if (SPLIT_AT == 5) (void)hipMemsetAsync((unsigned char*)d_ws + WS_CTL, 0, 128, stream);
#endif
    hipLaunchKernelGGL(mk_fwd, dim3(g_grid), dim3(NWAVES * 64), LDS_BYTES, stream, a);
#ifdef RUN_TWICE
    (void)hipMemsetAsync((unsigned char*)d_ws + WS_CTL, 0, 1 * MiB, stream);
    hipLaunchKernelGGL(mk_fwd, dim3(g_grid), dim3(NWAVES * 64), LDS_BYTES, stream, a);
#endif
}
```

```cpp
#include <hip/hip_runtime.h>
#include <stdint.h>
#include <stdio.h>

typedef unsigned short bf16_t;
#define DEV __device__ __forceinline__

DEV float bf2f(bf16_t v) { return __uint_as_float(((unsigned)v) << 16); }
DEV bf16_t f2bf(float f) { unsigned u = __float_as_uint(f); return (bf16_t)((u + 0x7fffu + ((u >> 16) & 1u)) >> 16); }
DEV float sigmoidf_(float x) { return 1.f / (1.f + __expf(-x)); }
DEV float gelu_tanh(float x) { const float u = 0.7978845608028654f * (x + 0.044715f * x * x * x); return x / (1.f + __expf(-2.f * u)); }
DEV float silu_(float x) { return x / (1.f + __expf(-x)); }

constexpr int T = 16384, D = 2048, SEQ = 4096, NIN = 3072, N1 = 7168, PW = 1024, SW = 1024, NE = 32, DE = 512, PLE = 256;
constexpr int CAP = 16384;
constexpr float EPS = 1e-6f;
constexpr float WGU_SCALE = 256.f, WD_SCALE = 128.f, HID_SCALE = 8.f, Y_SCALE = 16.f;

constexpr size_t MiB = 1u << 20;
constexpr size_t WS_CTL = 0;
constexpr size_t WS_SSQ = 256 * 1024;
constexpr size_t WS_PCNT = 512 * 1024;
constexpr size_t WS_MOERDY = 768 * 1024;
constexpr size_t WS_EID = 1 * MiB;
constexpr size_t WS_EW = 2 * MiB;
constexpr size_t WS_RSTD = 3 * MiB;
constexpr size_t WS_RSTD0 = 3 * MiB + 256 * 1024;
constexpr size_t WS_RSTD2 = 3 * MiB + 512 * 1024;
constexpr size_t WS_LIST = 4 * MiB;
constexpr size_t WS_WRH = 6 * MiB;
constexpr size_t WS_WRL = 7 * MiB;
constexpr size_t WS_W1T = 8 * MiB;
constexpr size_t WS_LNS = 20 * MiB;
constexpr size_t WS_W2T = 24 * MiB;
constexpr size_t WS_WPS = 30 * MiB;
constexpr size_t WS_WPT = 36 * MiB;
constexpr size_t WS_WSB = 36 * MiB + 512 * 1024;
constexpr size_t WS_WAT = 37 * MiB;
constexpr size_t WS_WBT = 41 * MiB;
constexpr size_t WS_WOT = 45 * MiB;
constexpr size_t WS_WPGT = 53 * MiB;
constexpr size_t WS_WPUT = 61 * MiB;
constexpr size_t WS_WGUT = 62 * MiB;
constexpr size_t WS_WDT = 190 * MiB;
constexpr size_t WS_PB = 254 * MiB;
constexpr size_t WS_XN = 262 * MiB;
constexpr size_t WS_AIN = 326 * MiB;
constexpr size_t WS_UU = 358 * MiB;
constexpr size_t WS_GV = 390 * MiB;
constexpr size_t WS_GATES = 422 * MiB;
constexpr size_t WS_MG = WS_AIN;
constexpr size_t WS_HID = WS_GV;
constexpr size_t WS_Y = WS_GATES;
constexpr size_t WS_X2B = WS_WGUT + 64 * MiB;
constexpr size_t WS_X2Q = WS_WDT + 32 * MiB;
constexpr size_t WS_XNQ = WS_X2B;
constexpr size_t WS_WMGQ = WS_X2Q;
constexpr size_t WS_END = 550 * MiB;
constexpr size_t OUT_X2B = 32 * MiB, OUT_X2Q = 96 * MiB;

#define LAS __attribute__((address_space(3)))
#define GAS __attribute__((address_space(1)))
typedef short bf16x8 __attribute__((ext_vector_type(8)));
typedef float f32x4 __attribute__((ext_vector_type(4)));
typedef float f32x2 __attribute__((ext_vector_type(2)));
typedef unsigned u32x4 __attribute__((ext_vector_type(4)));
typedef unsigned u32x2 __attribute__((ext_vector_type(2)));

namespace pg8 {
constexpr int BM = 256, BK = 64, HALF = 128, HTB = HALF * BK * 2, STAGE_BYTES = 8 * HTB, NXCD = 8, WGM = 8;
__host__ __device__ __forceinline__ int lds_byte(int r, int c) { const int st = (r >> 4) * 2 + (c >> 5), rr = r & 15, cc = c & 31, ob = rr * 64 + cc * 2; return st * 1024 + (ob ^ (((ob >> 9) & 1) << 5)); }
__host__ __device__ __forceinline__ void stage_rc(int b, int& R, int& C) { const int st = b / 1024, sb = b % 1024, swz = sb ^ (((sb >> 9) & 1) << 5); R = (st >> 1) * 16 + swz / 64; C = (st & 1) * 32 + (swz % 64) / 2; }
__host__ __device__ __forceinline__ int perm32(int rho) { const int n = rho >> 4, i = rho & 15; return 8 * (i >> 2) + 4 * n + (i & 3); }

enum { U_KEEP = 1 };
struct Unit { unsigned A; unsigned B; const int* rows; int pm, pn, flags, mvalid; };

DEV bool static_tile(int i, int G, int c, int nM, int nN, int& pm, int& pn) {
    const int nwg = nM * nN; const long L = (long)i * G + c; if (L >= nwg) return false;
    int wgid = (int)L; { const int q = nwg / NXCD, r = nwg % NXCD, xcd = wgid % NXCD, off = wgid / NXCD; wgid = (xcd < r ? xcd * (q + 1) : r * (q + 1) + (xcd - r) * q) + off; }
    const int nig = WGM * nN, gid = wgid / nig, fm = gid * WGM, gsz = (nM - fm) < WGM ? (nM - fm) : WGM;
    pm = fm + ((wgid % nig) % gsz); pn = (wgid % nig) / gsz; return true;
}
DEV unsigned cvt_pk_bf16(float lo, float hi) { unsigned r; asm volatile("v_cvt_pk_bf16_f32 %0, %1, %2" : "=v"(r) : "v"(lo), "v"(hi)); return r; }
DEV float fast_rcp(float x) { return __builtin_amdgcn_rcpf(x); }
DEV float fast_exp(float x) { return __builtin_amdgcn_exp2f(x * 1.4426950408889634f); }
DEV float sigm(float x) { return fast_rcp(1.f + fast_exp(-x)); }
DEV float sigm2(float t) { return fast_rcp(1.f + __builtin_amdgcn_exp2f(t)); }
DEV float gelu_t(float x) { const float t = x * (-2.3022082f - 0.10294324f * (x * x)); return x * fast_rcp(1.f + __builtin_amdgcn_exp2f(t)); }
DEV float silu_f(float x) { return x * fast_rcp(1.f + fast_exp(-x)); }
typedef int i32x8 __attribute__((ext_vector_type(8)));
typedef int i32x4 __attribute__((ext_vector_type(4)));
DEV unsigned pk4_fp8(float a, float b, float c, float d) { int w = __builtin_amdgcn_cvt_pk_fp8_f32(a, b, 0, false); w = __builtin_amdgcn_cvt_pk_fp8_f32(c, d, w, true); return (unsigned)w; }
DEV float clamp448(float v) { return __builtin_fminf(__builtin_fmaxf(v, -448.f), 448.f); }

template <class Epi, class Sched, bool ALIGN_EPI, bool GATHER, bool FP8 = false>
DEV void gemm_phase(LAS unsigned char* lds, const void* Abase, const void* Bbase, const unsigned lda, const unsigned ldb, const int nt_in, const int gshift, const Sched& S, const Epi& E, const int tid) {
    int nt = nt_in; asm volatile("" : "+s"(nt));
    const int wid = __builtin_amdgcn_readfirstlane(tid >> 6), lane = tid & 63, wr = wid >> 2, wc = wid & 3, fr = lane & 15, fq = lane >> 4;
    unsigned voffA[2], voffB[2];
#pragma unroll
    for (int i = 0; i < 2; ++i) { int R, C; stage_rc(tid * 16 + i * 8192, R, C); const int Rb = Epi::PERM ? ((R & ~31) + perm32(R & 31)) : R;
        voffA[i] = (unsigned)R * lda + (unsigned)C * 2u; voffB[i] = (unsigned)Rb * ldb + (unsigned)C * 2u; }
    const unsigned kstep = BK * 2u;
    const unsigned hstepA = HALF * lda, hstepB = HALF * ldb;
    const __amdgpu_buffer_rsrc_t rA = __builtin_amdgcn_make_buffer_rsrc(const_cast<void*>(Abase), 0, 0x7fffffff, 0x00020000), rB = __builtin_amdgcn_make_buffer_rsrc(const_cast<void*>(Bbase), 0, 0x7fffffff, 0x00020000);
    const unsigned ldsw = (unsigned)wid * 1024u;
    const int aoff = lds_byte(wr * 64 + fr, fq * 8), boff = lds_byte(wc * 32 + fr, fq * 8);
#define PG8_SA(b, h) (((b) * 2 + (h)) * HTB)
#define PG8_SB(b, h) ((4 + (b) * 2 + (h)) * HTB)
#define PG8_STG(bufoff, rs, voff, soff) do { _Pragma("unroll") for (int _i = 0; _i < 2; ++_i) \
        __builtin_amdgcn_raw_ptr_buffer_load_lds(rs, (LAS void*)(lds + (bufoff) + ldsw + _i * 8192), 16, (int)(voff)[_i], (int)(soff), 0, 0); } while (0)
#define PG8_STAGE_B(bufoff, soff) PG8_STG(bufoff, rB, voffB, soff)
#define PG8_STAGE_A(bufoff, soff, h) do { if constexpr (GATHER) { PG8_STG(bufoff, rA, gAc[h], soff); } else { PG8_STG(bufoff, rA, voffA, (soff) + (h) * hstepA); } } while (0)
#define PG8_LDA(dst, b, h) do { _Pragma("unroll") for (int m = 0; m < 4; ++m) _Pragma("unroll") for (int k = 0; k < 2; ++k) dst[m][k] = *(const LAS bf16x8*)(lds + PG8_SA(b, h) + aoff + m * 2048 + k * 1024); } while (0)
#define PG8_LDB(dst, b, h) do { _Pragma("unroll") for (int n = 0; n < 2; ++n) _Pragma("unroll") for (int k = 0; k < 2; ++k) dst[n][k] = *(const LAS bf16x8*)(lds + PG8_SB(b, h) + boff + n * 2048 + k * 1024); } while (0)
#define PG8_CAT(x, y) __builtin_shufflevector(__builtin_bit_cast(i32x4, x), __builtin_bit_cast(i32x4, y), 0, 1, 2, 3, 4, 5, 6, 7)
#define PG8_MMA(ai, bj, At, Bt) do { __builtin_amdgcn_s_setprio(1); _Pragma("unroll") for (int m = 0; m < 4; ++m) _Pragma("unroll") for (int n = 0; n < 2; ++n) { \
        if constexpr (FP8) acc[ai][bj][m][n] = __builtin_amdgcn_mfma_scale_f32_16x16x128_f8f6f4(PG8_CAT(Bt[n][0], Bt[n][1]), PG8_CAT(At[m][0], At[m][1]), acc[ai][bj][m][n], 0, 0, 0, 0, 0, 0); \
        else { _Pragma("unroll") for (int k = 0; k < 2; ++k) acc[ai][bj][m][n] = __builtin_amdgcn_mfma_f32_16x16x32_bf16(Bt[n][k], At[m][k], acc[ai][bj][m][n], 0, 0, 0); } } __builtin_amdgcn_s_setprio(0); } while (0)
#define PG8_WAIT_V(n) asm volatile("s_waitcnt vmcnt(" #n ")" ::: "memory")
#define PG8_WAIT_L(n) asm volatile("s_waitcnt lgkmcnt(" #n ")" ::: "memory")
#define PG8_BAR __builtin_amdgcn_s_barrier()
#define PG8_SCHED __builtin_amdgcn_sched_barrier(0)
    Unit cur, nxt; int ui = 0;
    if (!S.next(0, cur)) return;
    f32x4 acc[2][2][4][2];
#pragma unroll
    for (int a = 0; a < 2; ++a)
#pragma unroll
        for (int b = 0; b < 2; ++b)
#pragma unroll
            for (int m = 0; m < 4; ++m)
#pragma unroll
                for (int n = 0; n < 2; ++n) acc[a][b][m][n] = (f32x4){0.f, 0.f, 0.f, 0.f};
    bf16x8 At[4][2], B0[2][2], B1[2][2];
    unsigned gAc[2][2], gAn[2][2];
#define PG8_LOADROWS(u, dst) do { if constexpr (GATHER) { _Pragma("unroll") for (int h = 0; h < 2; ++h) _Pragma("unroll") for (int i = 0; i < 2; ++i) { int R, C; stage_rc(tid * 16 + i * 8192, R, C); \
        const int idx = h * HALF + R; const int e = (u).rows[idx < (u).mvalid ? idx : 0]; dst[h][i] = (unsigned)(e >> gshift) * lda + (unsigned)C * 2u; } } } while (0)
    PG8_LOADROWS(cur, gAc);
    unsigned cA = cur.A, cB = cur.B;
    S.a_ready(cur);
    PG8_STAGE_B(PG8_SB(0, 0), cB); PG8_STAGE_B(PG8_SB(0, 1), cB + hstepB); PG8_STAGE_A(PG8_SA(0, 0), cA, 0); PG8_STAGE_A(PG8_SA(0, 1), cA, 1);
    if (wr == 1) PG8_BAR;
    PG8_WAIT_V(2); PG8_BAR;
    PG8_STAGE_B(PG8_SB(1, 0), cB + kstep); PG8_STAGE_A(PG8_SA(1, 0), cA + kstep, 0); PG8_STAGE_B(PG8_SB(1, 1), cB + hstepB + kstep);
    PG8_WAIT_V(6); PG8_BAR;
    for (;;) {
        const bool has_next = S.next(ui + 1, nxt);
        if (has_next) { PG8_LOADROWS(nxt, gAn); } else if constexpr (GATHER) { _Pragma("unroll") for (int h = 0; h < 2; ++h) _Pragma("unroll") for (int i = 0; i < 2; ++i) gAn[h][i] = gAc[h][i]; }
        const unsigned nA = has_next ? nxt.A : cA, nB = has_next ? nxt.B : cB;
        for (int t = 0; t < nt; t += 2) {
            const bool last = (t == nt - 2);
            const unsigned a1 = cA + (unsigned)(t + 1) * kstep;
            const unsigned a2 = last ? nA : cA + (unsigned)(t + 2) * kstep, b2 = last ? nB : cB + (unsigned)(t + 2) * kstep;
            const unsigned a3 = a2 + kstep, b3 = b2 + kstep;
            if (last && has_next) S.a_ready(nxt);
            PG8_LDB(B0, 0, 0); PG8_LDB(B1, 0, 1); PG8_SCHED; PG8_LDA(At, 0, 0); PG8_STAGE_A(PG8_SA(1, 1), a1, 1);
            if constexpr (GATHER) { if (last) { _Pragma("unroll") for (int h = 0; h < 2; ++h) _Pragma("unroll") for (int i = 0; i < 2; ++i) gAc[h][i] = gAn[h][i]; } }
            PG8_WAIT_V(8); PG8_WAIT_L(0); PG8_BAR; PG8_MMA(0, 0, At, B0); PG8_MMA(0, 1, At, B1); PG8_BAR; PG8_SCHED;
            PG8_LDA(At, 0, 1); PG8_STAGE_B(PG8_SB(0, 0), b2); PG8_STAGE_B(PG8_SB(0, 1), b2 + hstepB); PG8_STAGE_A(PG8_SA(0, 0), a2, 0);
            PG8_WAIT_V(8); PG8_WAIT_L(0); PG8_BAR; PG8_MMA(1, 0, At, B0); PG8_MMA(1, 1, At, B1); PG8_BAR; PG8_SCHED;
            PG8_LDB(B0, 1, 0); PG8_LDB(B1, 1, 1); PG8_SCHED; PG8_LDA(At, 1, 0); PG8_STAGE_A(PG8_SA(0, 1), a2, 1);
            PG8_WAIT_V(8); PG8_WAIT_L(0); PG8_BAR; PG8_MMA(0, 0, At, B0); PG8_MMA(0, 1, At, B1); PG8_BAR; PG8_SCHED;
            PG8_LDA(At, 1, 1); PG8_STAGE_B(PG8_SB(1, 0), b3); PG8_STAGE_B(PG8_SB(1, 1), b3 + hstepB); PG8_STAGE_A(PG8_SA(1, 0), a3, 0);
            PG8_WAIT_V(8); PG8_WAIT_L(0); PG8_BAR; PG8_MMA(1, 0, At, B0); PG8_MMA(1, 1, At, B1); PG8_BAR; PG8_SCHED;
        }
        if constexpr (ALIGN_EPI) { if (wr == 0) PG8_BAR; }
        { int l_e; asm volatile("v_mbcnt_lo_u32_b32 %0, -1, 0\n\tv_mbcnt_hi_u32_b32 %0, -1, %0" : "=v"(l_e));
          E(acc, cur, wr, wc, l_e & 15, l_e >> 4); }
        S.done(cur);
        if (!(cur.flags & U_KEEP)) {
#pragma unroll
            for (int a = 0; a < 2; ++a)
#pragma unroll
                for (int b = 0; b < 2; ++b)
#pragma unroll
                    for (int m = 0; m < 4; ++m)
#pragma unroll
                        for (int n = 0; n < 2; ++n) acc[a][b][m][n] = (f32x4){0.f, 0.f, 0.f, 0.f};
        }
        if (!has_next) break;
        cur = nxt; cA = nA; cB = nB; ++ui;
        if constexpr (ALIGN_EPI) { if (wr == 1) PG8_BAR; }
    }
    PG8_WAIT_V(0);
    if constexpr (!ALIGN_EPI) { if (wr == 0) PG8_BAR; }
    PG8_BAR;
#undef PG8_SA
#undef PG8_SB
#undef PG8_STG
#undef PG8_STAGE_A
#undef PG8_STAGE_B
#undef PG8_LDA
#undef PG8_LDB
#undef PG8_MMA
#undef PG8_CAT
#undef PG8_WAIT_V
#undef PG8_WAIT_L
#undef PG8_BAR
#undef PG8_SCHED
#undef PG8_LOADROWS
}

typedef f32x4 Acc[2][2][4][2];
DEV u32x4 pack8(const f32x4 v0, const f32x4 v1) { u32x4 w; w.x = cvt_pk_bf16(v0[0], v0[1]); w.y = cvt_pk_bf16(v0[2], v0[3]); w.z = cvt_pk_bf16(v1[0], v1[1]); w.w = cvt_pk_bf16(v1[2], v1[3]); return w; }
DEV void unpack8(const u32x4 w, f32x4& v0, f32x4& v1) {
    v0[0] = __uint_as_float(w.x << 16); v0[1] = __uint_as_float(w.x & 0xffff0000u); v0[2] = __uint_as_float(w.y << 16); v0[3] = __uint_as_float(w.y & 0xffff0000u);
    v1[0] = __uint_as_float(w.z << 16); v1[1] = __uint_as_float(w.z & 0xffff0000u); v1[2] = __uint_as_float(w.w << 16); v1[3] = __uint_as_float(w.w & 0xffff0000u); }

struct EpiP1 {
    static constexpr bool PERM = true;
    bf16_t *AIN, *UU, *GV, *GATES; const float* bmg; float gsc;
    const float* rstd0;
    float* lns;
    DEV void operator()(Acc& acc, const Unit& u, int wr, int wc, int fr, int fq) const {
        const int pn = u.pn; int mode, ld, ct; bf16_t* base;
        if (pn < 4) { mode = 0; base = AIN; ld = 1024; ct = pn * 256; } else if (pn < 8) { mode = 1; base = UU; ld = 1024; ct = (pn - 4) * 256; }
        else if (pn < 12) { mode = 1; base = GV; ld = 1024; ct = (pn - 8) * 256; } else { mode = 2; base = GATES; ld = 4096; ct = (pn - 12) * 256; }
        const int row0 = u.pm * BM + wr * 64 + fr, col0 = ct + wc * 32 + 8 * fq;
        f32x4 bv[2][2];
#pragma unroll
        for (int bj = 0; bj < 2; ++bj)
#pragma unroll
            for (int n = 0; n < 2; ++n) bv[bj][n] = (mode == 2) ? *(const f32x4*)(bmg + col0 + bj * HALF + 4 * n) * -1.4426950408889634f : (f32x4){0.f, 0.f, 0.f, 0.f};
        float rs[2][4];
#pragma unroll
        for (int ai = 0; ai < 2; ++ai)
#pragma unroll
            for (int m = 0; m < 4; ++m) rs[ai][m] = rstd0[row0 + ai * HALF + m * 16] * (mode == 2 ? gsc * -1.4426950408889634f : gsc);
#pragma unroll
        for (int ai = 0; ai < 2; ++ai)
#pragma unroll
            for (int m = 0; m < 4; ++m) { bf16_t* rowp = base + (size_t)(row0 + ai * HALF + m * 16) * ld + col0; float s1 = 0.f, s2 = 0.f;
#pragma unroll
                for (int bj = 0; bj < 2; ++bj) { f32x4 v0 = acc[ai][bj][m][0] * rs[ai][m] + bv[bj][0], v1 = acc[ai][bj][m][1] * rs[ai][m] + bv[bj][1];
                    if (mode == 1) {
#pragma unroll
                        for (int j = 0; j < 4; ++j) { v0[j] = gelu_t(v0[j]); v1[j] = gelu_t(v1[j]); } }
                    else if (mode == 2) {
#pragma unroll
                        for (int j = 0; j < 4; ++j) { v0[j] = sigm2(v0[j]); v1[j] = sigm2(v1[j]); } }
                    if (pn >= 8 && pn < 12) {
#pragma unroll
                        for (int j = 0; j < 4; ++j) { s1 += v0[j] + v1[j]; s2 += v0[j] * v0[j] + v1[j] * v1[j]; } }
                    if (mode == 2) {
                        unsigned q0 = 0u, q1 = 0u;
                        q0 = __builtin_amdgcn_cvt_pk_u8_f32(v0[0] * 256.f - 0.5f, 0, q0); q0 = __builtin_amdgcn_cvt_pk_u8_f32(v0[1] * 256.f - 0.5f, 1, q0); q0 = __builtin_amdgcn_cvt_pk_u8_f32(v0[2] * 256.f - 0.5f, 2, q0); q0 = __builtin_amdgcn_cvt_pk_u8_f32(v0[3] * 256.f - 0.5f, 3, q0);
                        q1 = __builtin_amdgcn_cvt_pk_u8_f32(v1[0] * 256.f - 0.5f, 0, q1); q1 = __builtin_amdgcn_cvt_pk_u8_f32(v1[1] * 256.f - 0.5f, 1, q1); q1 = __builtin_amdgcn_cvt_pk_u8_f32(v1[2] * 256.f - 0.5f, 2, q1); q1 = __builtin_amdgcn_cvt_pk_u8_f32(v1[3] * 256.f - 0.5f, 3, q1);
                        u32x2 qq; qq.x = q0; qq.y = q1;
                        *(u32x2*)((unsigned char*)base + ((size_t)(u.pm * 16 + (pn - 12)) << 16) + ((((wr * 4 + wc) * 2 + ai) * 4 + m) * 2 + bj) * 512 + (fq * 16 + fr) * 8) = qq; }
                    else *(u32x4*)(rowp + bj * HALF) = pack8(v0, v1); }
                if (pn >= 8 && pn < 12) {
                    s1 += __shfl_xor(s1, 16); s2 += __shfl_xor(s2, 16); s1 += __shfl_xor(s1, 32); s2 += __shfl_xor(s2, 32);
                    if (fq == 0) { f32x2 pr; pr.x = s1; pr.y = s2; *(f32x2*)(lns + ((size_t)(row0 + ai * HALF + m * 16) * 16 + (pn - 8) * 4 + wc) * 2) = pr; } } }
    }
};
struct EpiBf16S {
    static constexpr bool PERM = true;
    bf16_t* O; int ld; const float* scale; int ri = 0;
    DEV void operator()(Acc& acc, const Unit& u, int wr, int wc, int fr, int fq) const {
        const int row0 = u.pm * BM + wr * 64 + fr, col0 = u.pn * BM + wc * 32 + 8 * fq;
#pragma unroll
        for (int bj = 0; bj < 2; ++bj) {
            f32x4 s0 = (f32x4){1.f, 1.f, 1.f, 1.f}, s1 = s0;
            if (scale) { s0 = *(const f32x4*)(scale + col0 + bj * HALF); s1 = *(const f32x4*)(scale + col0 + bj * HALF + 4); }
#pragma unroll
            for (int ai = 0; ai < 2; ++ai)
#pragma unroll
                for (int m = 0; m < 4; ++m) { const u32x4 w = pack8(acc[ai][bj][m][0] * s0, acc[ai][bj][m][1] * s1);
                    if (ri) *(u32x4*)((unsigned char*)O + ((size_t)(u.pm * (ld >> 8) + u.pn) << 17) + ((((wr * 4 + wc) * 2 + ai) * 4 + m) * 2 + bj) * 1024 + (fq * 16 + fr) * 16) = w;
                    else *(u32x4*)(O + (size_t)(row0 + ai * HALF + m * 16) * ld + col0 + bj * HALF) = w; } }
    }
};
struct EpiMerge {
    static constexpr bool PERM = true;
    const unsigned char* GATES; bf16_t* MG;
    static DEV void unq8(u32x2 w, f32x4& a, f32x4& b) {
        a[0] = (float)((w.x >> 0) & 0xffu); a[1] = (float)((w.x >> 8) & 0xffu); a[2] = (float)((w.x >> 16) & 0xffu); a[3] = (float)((w.x >> 24) & 0xffu);
        b[0] = (float)((w.y >> 0) & 0xffu); b[1] = (float)((w.y >> 8) & 0xffu); b[2] = (float)((w.y >> 16) & 0xffu); b[3] = (float)((w.y >> 24) & 0xffu);
        a = (a + 0.5f) * (1.f / 256.f); b = (b + 0.5f) * (1.f / 256.f); }
    DEV void operator()(Acc& acc, const Unit& u, int wr, int wc, int fr, int fq) const {
        const int row0 = u.pm * BM + wr * 64 + fr, col0 = u.pn * BM + wc * 32 + 8 * fq;
        const bool first = (u.flags & U_KEEP) != 0;
#pragma unroll
        for (int ai = 0; ai < 2; ++ai) {
            u32x2 gb[4][2], ga[4][2];
#pragma unroll
            for (int m = 0; m < 4; ++m)
#pragma unroll
                for (int bj = 0; bj < 2; ++bj) { const size_t fo = (size_t)(((((wr * 4 + wc) * 2 + ai) * 4 + m) * 2 + bj) * 512 + (fq * 16 + fr) * 8);
                    gb[m][bj] = *(const u32x2*)(GATES + ((size_t)(u.pm * 16 + u.pn + 8) << 16) + fo);
                    if (first) ga[m][bj] = *(const u32x2*)(GATES + ((size_t)(u.pm * 16 + u.pn) << 16) + fo); }
#pragma unroll
            for (int m = 0; m < 4; ++m)
#pragma unroll
                for (int bj = 0; bj < 2; ++bj) { const size_t r = (size_t)(row0 + ai * HALF + m * 16);
                    f32x4 b0, b1; unq8(gb[m][bj], b0, b1);
                    if (first) { f32x4 a0, a1; unq8(ga[m][bj], a0, a1);
#pragma unroll
                        for (int j = 0; j < 4; ++j) { acc[ai][bj][m][0][j] *= a0[j] * fast_rcp(b0[j]); acc[ai][bj][m][1][j] *= a1[j] * fast_rcp(b1[j]); } }
                    else *(u32x4*)(MG + r * 2048 + col0 + bj * HALF) = pack8(acc[ai][bj][m][0] * b0, acc[ai][bj][m][1] * b1); } }
    }
};
struct EpiResBf16 {
    static constexpr bool PERM = true;
    bf16_t* ob; unsigned char* oq;
    DEV void operator()(Acc& acc, const Unit& u, int wr, int wc, int fr, int fq) const {
        const int row0 = u.pm * BM + wr * 64 + fr, col0 = u.pn * BM + wc * 32 + 8 * fq;
#pragma unroll
        for (int ai = 0; ai < 2; ++ai) {
            u32x4 rv[4][2];
#pragma unroll
            for (int m = 0; m < 4; ++m)
#pragma unroll
                for (int bj = 0; bj < 2; ++bj) rv[m][bj] = *(const u32x4*)(ob + (size_t)(row0 + ai * HALF + m * 16) * 2048 + col0 + bj * HALF);
#pragma unroll
            for (int m = 0; m < 4; ++m)
#pragma unroll
                for (int bj = 0; bj < 2; ++bj) { const size_t off = (size_t)(row0 + ai * HALF + m * 16) * 2048 + col0 + bj * HALF; f32x4 r0, r1; unpack8(rv[m][bj], r0, r1);
                    const f32x4 v0 = r0 + acc[ai][bj][m][0], v1 = r1 + acc[ai][bj][m][1];
                    *(u32x4*)(ob + off) = pack8(v0, v1); u32x2 q; q.x = pk4_fp8(v0[0], v0[1], v0[2], v0[3]); q.y = pk4_fp8(v1[0], v1[1], v1[2], v1[3]); *(u32x2*)(oq + off) = q; } }
    }
};
struct EpiPleFinal {
    static constexpr bool PERM = true;
    const bf16_t* X2; const float* rstd; const float* bias; const bf16_t* PU; const float* gfin; float* out; float* ssq; unsigned* pcnt;
    DEV void operator()(Acc& acc, const Unit& u, int wr, int wc, int fr, int fq) const {
        const int row0 = u.pm * BM + wr * 64 + fr, col0 = u.pn * BM + wc * 32 + 8 * fq;
        int zdep = 0;
#pragma unroll
        for (int bj = 0; bj < 2; ++bj) {
            const f32x4 bv0 = *(const f32x4*)(bias + col0 + bj * HALF) * -1.4426950408889634f, bv1 = *(const f32x4*)(bias + col0 + bj * HALF + 4) * -1.4426950408889634f;
#pragma unroll
            for (int ai = 0; ai < 2; ++ai) {
                u32x4 xw[4], pw[4]; float rs[4];
#pragma unroll
                for (int m = 0; m < 4; ++m) { const size_t r = (size_t)(row0 + zdep + ai * HALF + m * 16); rs[m] = rstd[r] * (-1.4426950408889634f / WGU_SCALE);
                    xw[m] = *(const u32x4*)(X2 + r * 2048 + col0 + bj * HALF); pw[m] = *(const u32x4*)((const unsigned char*)PU + ((size_t)(u.pm * 8 + u.pn) << 17) + ((((wr * 4 + wc) * 2 + ai) * 4 + m) * 2 + bj) * 1024 + (fq * 16 + fr) * 16); }
#pragma unroll
                for (int m = 0; m < 4; ++m) { f32x4 x0, x1, p0, p1; unpack8(xw[m], x0, x1); unpack8(pw[m], p0, p1);
                    f32x4 g0 = acc[ai][bj][m][0] * rs[m] + bv0, g1 = acc[ai][bj][m][1] * rs[m] + bv1;
#pragma unroll
                    for (int q = 0; q < 4; ++q) { g0[q] = sigm2(g0[q]); g1[q] = sigm2(g1[q]); }
                    acc[ai][bj][m][0] = x0 + g0 * p0; acc[ai][bj][m][1] = x1 + g1 * p1; }
                asm volatile("" : "+v"(zdep), "+v"(acc[ai][bj][0][0]), "+v"(acc[ai][bj][1][0]), "+v"(acc[ai][bj][2][0]), "+v"(acc[ai][bj][3][0]), "+v"(acc[ai][bj][0][1]), "+v"(acc[ai][bj][1][1]), "+v"(acc[ai][bj][2][1]), "+v"(acc[ai][bj][3][1])); } }
        float sqv[2][4];
#pragma unroll
        for (int ai = 0; ai < 2; ++ai)
#pragma unroll
            for (int m = 0; m < 4; ++m) { float sq = 0.f;
#pragma unroll
                for (int bj = 0; bj < 2; ++bj)
#pragma unroll
                    for (int n = 0; n < 2; ++n) { const f32x4 v = acc[ai][bj][m][n]; sq += (v[0] * v[0] + v[1] * v[1]) + (v[2] * v[2] + v[3] * v[3]); }
                sq += __shfl_xor(sq, 16); sq += __shfl_xor(sq, 32); sqv[ai][m] = sq; }
        if (fq == 0) {
#pragma unroll
            for (int ai = 0; ai < 2; ++ai)
#pragma unroll
                for (int m = 0; m < 4; ++m) atomicAdd(ssq + row0 + ai * HALF + m * 16, sqv[ai][m]); }
        asm volatile("s_waitcnt vmcnt(0)" ::: "memory");
        unsigned* pc = pcnt + 64 * u.pm;
        if (fr == 0 && fq == 0) __hip_atomic_fetch_add(pc, 1u, __ATOMIC_RELAXED, __HIP_MEMORY_SCOPE_AGENT);
        { unsigned spins = 0; while ((unsigned)__builtin_amdgcn_readfirstlane((int)__hip_atomic_load(pc, __ATOMIC_RELAXED, __HIP_MEMORY_SCOPE_AGENT)) < 64u) { __builtin_amdgcn_s_sleep(2); if (++spins > (1u << 20)) break; } }
        float rsf[2][4];
#pragma unroll
        for (int ai = 0; ai < 2; ++ai)
#pragma unroll
            for (int m = 0; m < 4; ++m) rsf[ai][m] = rsqrtf(__hip_atomic_load(ssq + row0 + ai * HALF + m * 16, __ATOMIC_RELAXED, __HIP_MEMORY_SCOPE_AGENT) * (1.f / 2048.f) + 1e-6f);
#pragma unroll
        for (int bj = 0; bj < 2; ++bj) {
            const f32x4 g0 = *(const f32x4*)(gfin + col0 + bj * HALF), g1 = *(const f32x4*)(gfin + col0 + bj * HALF + 4);
#pragma unroll
            for (int ai = 0; ai < 2; ++ai)
#pragma unroll
                for (int m = 0; m < 4; ++m) {
                    const f32x4 o0 = acc[ai][bj][m][0] * rsf[ai][m] * g0, o1 = acc[ai][bj][m][1] * rsf[ai][m] * g1; f32x4 na, nb;
#pragma unroll
                    for (int q = 0; q < 4; ++q) { const auto r = __builtin_amdgcn_permlane32_swap(__float_as_uint(o0[q]), __float_as_uint(o1[q]), false, false); na[q] = __uint_as_float(r[0]); nb[q] = __uint_as_float(r[1]); }
                    float* op = out + (size_t)(row0 + ai * HALF + m * 16) * 2048 + (col0 - 8 * fq) + bj * HALF;
                    *(f32x4*)(op + (fq < 2 ? 8 * fq : 8 * (fq - 2) + 4)) = na; *(f32x4*)(op + (fq < 2 ? 16 + 8 * fq : 8 * fq + 4)) = nb; } }
    }
};
struct EpiMoe1 {
    static constexpr bool PERM = true;
    unsigned char* HID; const float* rstd;
    DEV void operator()(Acc& acc, const Unit& u, int wr, int wc, int fr, int fq) const {
        const int col0 = u.pn * HALF + wc * 32 + 8 * fq;
        int aid[2][4];
#pragma unroll
        for (int ai = 0; ai < 2; ++ai)
#pragma unroll
            for (int m = 0; m < 4; ++m) { const int idx = ai * HALF + wr * 64 + m * 16 + fr; aid[ai][m] = u.rows[idx < u.mvalid ? idx : 0]; }
        float rsv[2][4];
#pragma unroll
        for (int ai = 0; ai < 2; ++ai)
#pragma unroll
            for (int m = 0; m < 4; ++m) rsv[ai][m] = rstd[aid[ai][m] >> 1];
#pragma unroll
        for (int ai = 0; ai < 2; ++ai)
#pragma unroll
            for (int m = 0; m < 4; ++m) { const int idx = ai * HALF + wr * 64 + m * 16 + fr;
                if (idx < u.mvalid) { f32x4 h0, h1; const float rs = rsv[ai][m] * (1.f / WGU_SCALE);
#pragma unroll
                    for (int j = 0; j < 4; ++j) { h0[j] = silu_f(rs * acc[ai][0][m][0][j]) * (rs * acc[ai][1][m][0][j]); h1[j] = silu_f(rs * acc[ai][0][m][1][j]) * (rs * acc[ai][1][m][1][j]); }
                    u32x2 q; q.x = pk4_fp8(clamp448(h0[0] * HID_SCALE), clamp448(h0[1] * HID_SCALE), clamp448(h0[2] * HID_SCALE), clamp448(h0[3] * HID_SCALE));
                    q.y = pk4_fp8(clamp448(h1[0] * HID_SCALE), clamp448(h1[1] * HID_SCALE), clamp448(h1[2] * HID_SCALE), clamp448(h1[3] * HID_SCALE));
                    __hip_atomic_store((unsigned long long*)(HID + (size_t)aid[ai][m] * 512 + col0), ((unsigned long long)q.y << 32) | q.x, __ATOMIC_RELAXED, __HIP_MEMORY_SCOPE_AGENT); } }
    }
};
struct EpiMoe2 {
    static constexpr bool PERM = true;
    unsigned char* Y; const float* ew;
    DEV void operator()(Acc& acc, const Unit& u, int wr, int wc, int fr, int fq) const {
        const int col0 = u.pn * BM + wc * 32 + 8 * fq;
        int aid[2][4]; float wv[2][4];
#pragma unroll
        for (int ai = 0; ai < 2; ++ai)
#pragma unroll
            for (int m = 0; m < 4; ++m) { const int idx = ai * HALF + wr * 64 + m * 16 + fr; aid[ai][m] = u.rows[idx < u.mvalid ? idx : 0]; }
#pragma unroll
        for (int ai = 0; ai < 2; ++ai)
#pragma unroll
            for (int m = 0; m < 4; ++m) wv[ai][m] = ew[aid[ai][m]] * (Y_SCALE / (HID_SCALE * WD_SCALE));
#pragma unroll
        for (int ai = 0; ai < 2; ++ai)
#pragma unroll
            for (int m = 0; m < 4; ++m) { const int idx = ai * HALF + wr * 64 + m * 16 + fr;
                if (idx < u.mvalid) {
#pragma unroll
                    for (int bj = 0; bj < 2; ++bj) { const f32x4 v0 = acc[ai][bj][m][0] * wv[ai][m], v1 = acc[ai][bj][m][1] * wv[ai][m];
                        u32x2 q; q.x = pk4_fp8(clamp448(v0[0]), clamp448(v0[1]), clamp448(v0[2]), clamp448(v0[3])); q.y = pk4_fp8(clamp448(v1[0]), clamp448(v1[1]), clamp448(v1[2]), clamp448(v1[3]));
                        *(u32x2*)(Y + (size_t)aid[ai][m] * 2048 + col0 + bj * HALF) = q; } } }
    }
};

struct SchedDense {
    unsigned lda, ldb; int nM, nN, G, c; int i0 = 0, iend = 1 << 30; int pn_off = 0;
    DEV bool next(int i, Unit& u) const { int pm, pn; if (i + i0 >= iend || !static_tile(i + i0, G, c, nM, nN, pm, pn)) return false;
        u.A = (unsigned)pm * BM * lda; u.B = (unsigned)pn * BM * ldb; u.rows = nullptr; u.pm = pm; u.pn = pn + pn_off; u.flags = 0; u.mvalid = BM; return true; }
    DEV void a_ready(const Unit&) const {} DEV void done(const Unit&) const {}
};
struct SchedDual {
    unsigned A1off, B1off; unsigned lda, ldb; int nM, nN, G, c;
    DEV bool next(int i, Unit& u) const { int pm, pn; if (!static_tile(i >> 1, G, c, nM, nN, pm, pn)) return false; const bool second = i & 1;
        u.A = (second ? A1off : 0u) + (unsigned)pm * BM * lda; u.B = (second ? B1off : 0u) + (unsigned)pn * BM * ldb; u.rows = nullptr; u.pm = pm; u.pn = pn; u.flags = second ? 0 : U_KEEP; u.mvalid = BM; return true; }
    DEV void a_ready(const Unit&) const {} DEV void done(const Unit&) const {}
};
struct SchedMoe {
    unsigned bestep; unsigned ldb; const int* list; const LAS int* pre; const LAS int* cl; int NT, G, c;
    unsigned* ready; int role, wave; int E = 0, SK = 0;
    DEV bool next(int i, Unit& u) const {
        const int total = __builtin_amdgcn_readfirstlane(pre[32]);
        const int x = c >> 5, k = c & 31, NX8 = G >> 5; const bool spread = (G & 31) == 0;
        long L;
        if (role == 1) { const long U = (long)total * NT; const int full = (int)(U / G);
            L = (i < full || !spread) ? (long)i * G + c : (i == full ? (long)full * G + (k * NX8 + x) : U); }
        else { bool extra; int rank;
            if (spread) { const int nx = (E - x + NX8 - 1) / NX8 > 0 ? (E - x + NX8 - 1) / NX8 : 0; extra = k < nx; int below = 0; for (int q = 0; q < x; ++q) { const int nq = (E - q + NX8 - 1) / NX8; below += nq > 0 ? nq : 0; } rank = c - below - (k < nx ? k : nx); }
            else { extra = c < E; rank = c - E; }
            L = extra ? (long)SK * (G - E) + (long)i * G + c : (i < SK ? (long)i * (G - E) + rank : (long)SK * (G - E) + (long)(i - SK) * G + c); }
        if (L >= (long)total * NT) return false;
        const int rt = (int)(L / NT), pn = (int)(L % NT); int e = 0;
        for (int q = 1; q < 32; ++q) e += (pre[q] <= rt) ? 1 : 0;
        e = __builtin_amdgcn_readfirstlane(e);
        const int lt = rt - __builtin_amdgcn_readfirstlane(pre[e]); const int n = __builtin_amdgcn_readfirstlane(cl[e]);
        u.A = 0u; u.B = (unsigned)e * bestep + (unsigned)pn * BM * ldb; u.rows = list + e * CAP + lt * BM; u.pm = rt; u.pn = pn; u.flags = 0; u.mvalid = (n - lt * BM) < BM ? (n - lt * BM) : BM; return true; }
    DEV void a_ready(const Unit& u) const {
        if (role != 2) return;
        if (wave == 0) { unsigned* p = ready + 64 * u.pm; unsigned spins = 0;
            while ((unsigned)__builtin_amdgcn_readfirstlane((int)__hip_atomic_load(p, __ATOMIC_RELAXED, __HIP_MEMORY_SCOPE_AGENT)) < 32u) { __builtin_amdgcn_s_sleep(2); if (++spins > (1u << 20)) break; }
            __builtin_amdgcn_fence(__ATOMIC_ACQUIRE, "agent");
            asm volatile("s_waitcnt vmcnt(0)" ::: "memory"); }
        asm volatile("" ::: "memory"); __builtin_amdgcn_s_barrier(); asm volatile("" ::: "memory");
    }
    DEV void done(const Unit& u) const {
        if (role != 1) return;
        asm volatile("s_waitcnt vmcnt(0)" ::: "memory");
        if (__builtin_amdgcn_mbcnt_hi(~0u, __builtin_amdgcn_mbcnt_lo(~0u, 0u)) == 0u) __hip_atomic_fetch_add(ready + 64 * u.pm, 1u, __ATOMIC_RELAXED, __HIP_MEMORY_SCOPE_AGENT);
    }
};
struct SchedPanel {
    unsigned lda, ldb; int nM, G, v;
    DEV bool next(int i, Unit& u) const { const int pm = i * (G >> 3) + (v >> 3), pn = v & 7; if (pm >= nM) return false;
        u.A = (unsigned)pm * BM * lda; u.B = (unsigned)pn * BM * ldb; u.rows = nullptr; u.pm = pm; u.pn = pn; u.flags = 0; u.mvalid = BM; return true; }
    DEV void a_ready(const Unit&) const {} DEV void done(const Unit&) const {}
};
struct SchedOne { Unit u0; DEV bool next(int i, Unit& u) const { if (i != 0) return false; u = u0; return true; } DEV void a_ready(const Unit&) const {} DEV void done(const Unit&) const {} };
}

#define XB_TMO      128
#define XB_XCNT(j)  (256  + 64 * (j))
#define XB_XSUB(j)  (1280 + 64 * (j))
#define XB_XGEN(j)  (2304 + 64 * (j))
#define XB_TOP      3328
#define XB_TOPGEN   3392
#define XCD_BAR_WORDS 3456
#define XB_SPIN_CAP (1u << 18)
DEV unsigned xb_ld(unsigned* p)              { return __hip_atomic_load(p, __ATOMIC_RELAXED, __HIP_MEMORY_SCOPE_AGENT); }
DEV unsigned xb_add(unsigned* p, unsigned v) { return __hip_atomic_fetch_add(p, v, __ATOMIC_RELAXED, __HIP_MEMORY_SCOPE_AGENT); }
DEV unsigned xb_xcc_id() { return (unsigned)__builtin_amdgcn_s_getreg((3 << 11) | 20) & 0xFu; }
#define XB_SPIN(cond, bar) do { unsigned _sp = 0; while (cond) { __builtin_amdgcn_s_sleep(1); \
    if ((++_sp & 255u) == 0u) { if (xb_ld(&(bar)[XB_TMO])) break; if (_sp > XB_SPIN_CAP) { atomicAdd(&(bar)[XB_TMO], 1u); break; } } } } while (0)
struct XcdBarrier { unsigned* bar; unsigned x; volatile LAS unsigned* st; };
DEV XcdBarrier xcd_barrier_post(unsigned* bar, volatile LAS unsigned* st) {
    XcdBarrier b; b.bar = bar; b.x = xb_xcc_id(); b.st = st;
    if (threadIdx.x == 0) (void)xb_add(&bar[XB_XCNT(b.x)], 1u);
    return b;
}
DEV void xcd_barrier_complete(unsigned* bar, unsigned x, unsigned& nloc, unsigned& nx) {
    const unsigned G = gridDim.x * gridDim.y * gridDim.z;
    unsigned sum, cnt, mine, sp = 0u;
    for (;;) {
        sum = 0u; cnt = 0u; mine = 0u;
#pragma unroll
        for (unsigned j = 0; j < 16; ++j) { const unsigned c = xb_ld(&bar[XB_XCNT(j)]); sum += c; cnt += (c > 0u) ? 1u : 0u; mine = (j == x) ? c : mine; }
        if (sum == G) break;
        __builtin_amdgcn_s_sleep(1);
        if ((++sp & 255u) == 0u) { if (xb_ld(&bar[XB_TMO])) break; if (sp > XB_SPIN_CAP) { atomicAdd(&bar[XB_TMO], 1u); break; } }
    }
    nloc = mine > 0u ? mine : 1u; nx = cnt > 0u ? cnt : 1u;
}
DEV void xcd_barrier(const XcdBarrier& b, const int wave_s) {
    asm volatile("s_waitcnt vmcnt(0)" ::: "memory");
    __syncthreads();
    if (wave_s == 0 && __builtin_amdgcn_mbcnt_hi(~0u, __builtin_amdgcn_mbcnt_lo(~0u, 0u)) == 0u) {
        unsigned* bar = b.bar;
        __builtin_amdgcn_s_waitcnt(0);
        __builtin_amdgcn_fence(__ATOMIC_ACQUIRE, "agent");
        unsigned nloc = b.st[0], nx = b.st[1];
        if (nloc == 0u) { xcd_barrier_complete(bar, b.x, nloc, nx); b.st[0] = nloc; b.st[1] = nx; }
        const unsigned old = xb_add(&bar[XB_XSUB(b.x)], 1u);
        const unsigned gen = old / nloc;
        if (old + 1u == (gen + 1u) * nloc) {
            __builtin_amdgcn_fence(__ATOMIC_RELEASE, "agent");
            asm volatile("s_waitcnt vmcnt(0)" ::: "memory");
            const unsigned og = xb_add(&bar[XB_TOP], 1u);
            const unsigned tg = og / nx;
            if (og + 1u == (tg + 1u) * nx) xb_add(&bar[XB_TOPGEN], 1u);
            else XB_SPIN(xb_ld(&bar[XB_TOPGEN]) == tg, bar);
            xb_add(&bar[XB_XGEN(b.x)], 1u);
            asm volatile("s_waitcnt vmcnt(0)" ::: "memory");
        } else {
            XB_SPIN(xb_ld(&bar[XB_XGEN(b.x)]) == gen, bar);
            asm volatile("s_waitcnt vmcnt(0)" ::: "memory");
        }
    }
    __syncthreads();
}


#define LDS_WAIT() asm volatile("s_waitcnt lgkmcnt(0)" ::: "memory")
#define VM_WAIT() asm volatile("s_waitcnt vmcnt(0)" ::: "memory")
DEV float wave_sum(float v) {
#pragma unroll
    for (int o = 1; o < 64; o <<= 1) v += __shfl_xor(v, o);
    return v;
}
DEV unsigned pk2(float lo, float hi) { return pg8::cvt_pk_bf16(lo, hi); }
struct ItemD { const float* src; unsigned char* dst; const float* ks; int N, K; float cs; int q8; };
DEV bool item_try(int& r, ItemD& d, const float* W, int K, int N, int batch, long sstride, long dstride, void* WT, int mode, int row_off, const float* kscale, float cs, int q8, int ld = 0) {
    const int ik = q8 ? 128 : 64, in = q8 ? 32 : 64;
    const int nnb = N / in, per = (K / ik) * nnb, tot = per * batch;
    if (r >= tot) { r -= tot; return false; }
    const int b = r / per, q = r % per, k0 = (q / nnb) * ik, n0 = (q % nnb) * in;
    const int drow0 = mode == 0 ? row_off + n0 : 256 * (n0 >> 7) + (n0 & 127) + (mode == 2 ? 128 : 0);
    const int ldn = ld ? ld : N;
    d.src = W + (size_t)b * sstride + (size_t)k0 * ldn + n0; d.N = ldn; d.K = K; d.cs = cs; d.q8 = q8; d.ks = kscale ? kscale + k0 : nullptr;
    d.dst = (unsigned char*)WT + ((size_t)b * dstride + (size_t)drow0 * K + k0) * (q8 ? 1 : 2);
    return true;
}
DEV void item_load(const ItemD& d, f32x4 (&v)[16], f32x4 (&sc)[4], int lane) {
    const int kk = d.q8 ? lane >> 3 : lane >> 4, nq = d.q8 ? lane & 7 : lane & 15;
#pragma unroll
    for (int t = 0; t < 4; ++t) sc[t] = d.ks ? *(const f32x4*)(d.ks + 16 * kk + 4 * t) : (f32x4){1.f, 1.f, 1.f, 1.f};
    const float* p = d.src + (size_t)(16 * kk) * d.N + 4 * nq;
#pragma unroll
    for (int i = 0; i < 16; ++i) v[i] = __builtin_nontemporal_load((const f32x4*)(p + (size_t)i * d.N));
}
DEV void item_finish(const ItemD& d, const f32x4 (&v)[16], const f32x4 (&sc)[4], int lane) {
    const int kk = d.q8 ? lane >> 3 : lane >> 4, nq = d.q8 ? lane & 7 : lane & 15; const float cs = d.cs;
#pragma unroll
    for (int c = 0; c < 4; ++c) {
        float e[16];
#pragma unroll
        for (int i = 0; i < 16; ++i) e[i] = v[i][c] * (sc[i >> 2][i & 3] * cs);
        if (d.q8) { u32x4 o; o.x = pg8::pk4_fp8(e[0], e[1], e[2], e[3]); o.y = pg8::pk4_fp8(e[4], e[5], e[6], e[7]); o.z = pg8::pk4_fp8(e[8], e[9], e[10], e[11]); o.w = pg8::pk4_fp8(e[12], e[13], e[14], e[15]);
            u32x4* op = (u32x4*)(d.dst + (size_t)(4 * nq + c) * d.K + 16 * kk); if (d.q8 & 2) __builtin_nontemporal_store(o, op); else *op = o; }
        else { u32x4 o0, o1; o0.x = pk2(e[0], e[1]); o0.y = pk2(e[2], e[3]); o0.z = pk2(e[4], e[5]); o0.w = pk2(e[6], e[7]); o1.x = pk2(e[8], e[9]); o1.y = pk2(e[10], e[11]); o1.z = pk2(e[12], e[13]); o1.w = pk2(e[14], e[15]);
            unsigned char* p = d.dst + ((size_t)(4 * nq + c) * d.K + 16 * kk) * 2; *(u32x4*)p = o0; *(u32x4*)(p + 16) = o1; } }
}
#define ITEM_STREAM(DEC, first, stride, count, lane) do { \
    ItemD dc_, dn_; f32x4 vc_[16], vn_[16], sc_[4], sn_[4]; int it_ = (first); \
    if (it_ < (count)) { DEC(it_, dc_); item_load(dc_, vc_, sc_, lane); \
        for (;;) { const int itn_ = it_ + (stride); const bool hn_ = itn_ < (count); \
            if (hn_) { DEC(itn_, dn_); item_load(dn_, vn_, sn_, lane); } \
            item_finish(dc_, vc_, sc_, lane); \
            if (!hn_) break; \
            dc_ = dn_; _Pragma("unroll") for (int q_ = 0; q_ < 16; ++q_) vc_[q_] = vn_[q_]; _Pragma("unroll") for (int q_ = 0; q_ < 4; ++q_) sc_[q_] = sn_[q_]; it_ = itn_; } } } while (0)
DEV void rms_row_q(const float* xrow, bf16_t* orow, unsigned char* oq, float* rstd_out, int lane) {
    f32x4 v[8]; float s = 0.f;
#pragma unroll
    for (int q = 0; q < 8; ++q) v[q] = __builtin_nontemporal_load((const f32x4*)xrow + lane + 64 * q);
#pragma unroll
    for (int q = 0; q < 8; ++q) { s += (v[q][0] * v[q][0] + v[q][1] * v[q][1]) + (v[q][2] * v[q][2] + v[q][3] * v[q][3]);
        u32x2 o; o.x = pk2(v[q][0], v[q][1]); o.y = pk2(v[q][2], v[q][3]); *((u32x2*)orow + lane + 64 * q) = o;
        *((unsigned*)oq + lane + 64 * q) = pg8::pk4_fp8(v[q][0], v[q][1], v[q][2], v[q][3]); }
    s = wave_sum(s);
    if (lane == 0) *rstd_out = rsqrtf(s * (1.f / D) + EPS);
}
DEV void x2_row(const bf16_t* xrow, const unsigned char* y0, const unsigned char* y1, bf16_t* orow, unsigned char* oq, float* rstd_out, int lane) {
    u32x4 a[4]; u32x2 b[4], c[4];
#pragma unroll
    for (int j = 0; j < 4; ++j) { a[j] = *((const u32x4*)xrow + lane + 64 * j); b[j] = *((const u32x2*)y0 + lane + 64 * j); c[j] = *((const u32x2*)y1 + lane + 64 * j); }
    float s = 0.f;
#pragma unroll
    for (int j = 0; j < 4; ++j) { f32x4 v0, v1; pg8::unpack8(a[j], v0, v1);
        const f32x2 b0 = __builtin_amdgcn_cvt_pk_f32_fp8((int)b[j].x, false), b1 = __builtin_amdgcn_cvt_pk_f32_fp8((int)b[j].x, true), b2 = __builtin_amdgcn_cvt_pk_f32_fp8((int)b[j].y, false), b3 = __builtin_amdgcn_cvt_pk_f32_fp8((int)b[j].y, true);
        const f32x2 c0 = __builtin_amdgcn_cvt_pk_f32_fp8((int)c[j].x, false), c1 = __builtin_amdgcn_cvt_pk_f32_fp8((int)c[j].x, true), c2 = __builtin_amdgcn_cvt_pk_f32_fp8((int)c[j].y, false), c3 = __builtin_amdgcn_cvt_pk_f32_fp8((int)c[j].y, true);
        const float is = 1.f / Y_SCALE;
        v0[0] += (b0.x + c0.x) * is; v0[1] += (b0.y + c0.y) * is; v0[2] += (b1.x + c1.x) * is; v0[3] += (b1.y + c1.y) * is;
        v1[0] += (b2.x + c2.x) * is; v1[1] += (b2.y + c2.y) * is; v1[2] += (b3.x + c3.x) * is; v1[3] += (b3.y + c3.y) * is;
        s += ((v0[0] * v0[0] + v0[1] * v0[1]) + (v0[2] * v0[2] + v0[3] * v0[3])) + ((v1[0] * v1[0] + v1[1] * v1[1]) + (v1[2] * v1[2] + v1[3] * v1[3]));
        *((u32x4*)orow + lane + 64 * j) = pg8::pack8(v0, v1);
        u32x2 q; q.x = pg8::pk4_fp8(v0[0], v0[1], v0[2], v0[3]); q.y = pg8::pk4_fp8(v1[0], v1[1], v1[2], v1[3]); *((u32x2*)oq + lane + 64 * j) = q; }
    s = wave_sum(s);
    if (lane == 0) *rstd_out = rsqrtf(s * (1.f / D) + EPS);
}
DEV void zp_block(const bf16_t* AIN, bf16_t* ZP, int pm, int g, int tid) {
    const int c8 = tid & 31, run = tid >> 5, w = 2 << g;
    const int R0 = pm * 256 + run * 16, seq0 = R0 & ~(SEQ - 1), col = g * 256 + c8 * 8;
    u32x4 raw[31];
#pragma unroll
    for (int i = 0; i < 31; ++i) { const int R = R0 - 15 + i; raw[i] = *(const u32x4*)(AIN + (size_t)(R >= seq0 ? R : R0) * PW + col); }
    f32x4 s0 = (f32x4){0.f, 0.f, 0.f, 0.f}, s1 = s0;
#pragma unroll
    for (int i = 0; i < 15; ++i) { const int R = R0 - 15 + i; f32x4 a0, a1; pg8::unpack8(raw[i], a0, a1); const bool in = (15 - i) < w && R >= seq0; if (in) { s0 += a0; s1 += a1; } }
#pragma unroll
    for (int i = 0; i < 16; ++i) { const int R = R0 + i; f32x4 a0, a1; pg8::unpack8(raw[15 + i], a0, a1);
        s0 += a0; s1 += a1;
        const int tt = R - seq0; const float inv = 1.f / (float)((tt + 1 < w) ? tt + 1 : w);
        *(u32x4*)(ZP + (size_t)R * PW + col) = pg8::pack8(s0 * inv - a0, s1 * inv - a1);
        f32x4 b0, b1;
        if (w == 2) pg8::unpack8(raw[15 + i - 1], b0, b1); else if (w == 4) pg8::unpack8(raw[15 + i - 3], b0, b1); else if (w == 8) pg8::unpack8(raw[15 + i - 7], b0, b1); else pg8::unpack8(raw[i], b0, b1);
        if (R - w + 1 >= seq0) { s0 -= b0; s1 -= b1; } }
}
constexpr int VT_STRIDE = 272;
DEV void sgu_unit(LAS unsigned char* lds, const float* LNS, const bf16_t* GV, const bf16_t* UU, const bf16_t* WSb, const float* bsp, const float* lg, const float* lb, bf16_t* SB, int nb, int hf, int tid) {
    const int lane = tid & 63, wave = __builtin_amdgcn_readfirstlane(tid >> 6), fr = lane & 15, fq = lane >> 4;
    LAS float* st = (LAS float*)lds;
    LAS unsigned char* vt = lds + 2048;
    const int t0 = nb * 128;
    if (tid < 128) { float s1 = 0.f, s2 = 0.f; const f32x4* lp = (const f32x4*)(LNS + (size_t)(t0 + tid) * 32);
#pragma unroll
        for (int k = 0; k < 8; ++k) { const f32x4 q = lp[k]; s1 += q[0]; s2 += q[1]; s1 += q[2]; s2 += q[3]; }
        const float mean = s1 * (1.f / SW), var = __builtin_fmaxf(s2 * (1.f / SW) - mean * mean, 0.f);
        st[2 * tid] = mean; st[2 * tid + 1] = rsqrtf(var + EPS); }
    __syncthreads();
    const int half = wave >> 2, wv = wave & 3, th = tid & 255;
    LAS unsigned char* vb = vt + half * (128 * VT_STRIDE);
    for (int rd = 0; rd < 2; ++rd) { const int g = hf * 4 + rd * 2 + half;
        const int s4 = th & 31, c8a = th >> 5;
        f32x4 lgv[2][2], lbv[2][2]; u32x4 gvr[2][4];
#pragma unroll
        for (int h = 0; h < 2; ++h) { const int cg = g * 128 + (c8a + 8 * h) * 8; lgv[h][0] = *(const f32x4*)(lg + cg); lgv[h][1] = *(const f32x4*)(lg + cg + 4); lbv[h][0] = *(const f32x4*)(lb + cg); lbv[h][1] = *(const f32x4*)(lb + cg + 4); }
#pragma unroll
        for (int h = 0; h < 2; ++h)
#pragma unroll
            for (int i = 0; i < 4; ++i) gvr[h][i] = *(const u32x4*)(GV + (size_t)(t0 + 4 * s4 + i) * SW + g * 128 + (c8a + 8 * h) * 8);
        bf16x8 wf[2][4]; u32x2 uws[2][8]; float bias[2];
#pragma unroll
        for (int tb = 0; tb < 2; ++tb)
#pragma unroll
            for (int kk = 0; kk < 4; ++kk) wf[tb][kk] = *(const bf16x8*)(WSb + (size_t)(g * 128 + (wv + 4 * tb) * 16 + fr) * 128 + kk * 32 + fq * 8);
#pragma unroll
        for (int tb = 0; tb < 2; ++tb) { bias[tb] = bsp[g * 128 + (wv + 4 * tb) * 16 + fr];
#pragma unroll
            for (int cb = 0; cb < 8; ++cb) uws[tb][cb] = *(const u32x2*)(UU + (size_t)(t0 + (wv + 4 * tb) * 16 + fr) * SW + g * 128 + cb * 16 + fq * 4); }
        if (rd) __syncthreads();
#pragma unroll
        for (int h = 0; h < 2; ++h) { const int c8 = c8a + 8 * h; f32x4 v0[4], v1[4];
#pragma unroll
            for (int i = 0; i < 4; ++i) { const int r = 4 * s4 + i; pg8::unpack8(gvr[h][i], v0[i], v1[i]);
                const float mean = st[2 * r], rstd = st[2 * r + 1]; v0[i] = (v0[i] - mean) * rstd * lgv[h][0] + lbv[h][0]; v1[i] = (v1[i] - mean) * rstd * lgv[h][1] + lbv[h][1]; }
#pragma unroll
            for (int q = 0; q < 4; ++q) { u32x2 o; o.x = pk2(v0[0][q], v0[1][q]); o.y = pk2(v0[2][q], v0[3][q]); *(LAS u32x2*)(vb + (c8 * 8 + q) * VT_STRIDE + s4 * 8) = o;
                u32x2 o2; o2.x = pk2(v1[0][q], v1[1][q]); o2.y = pk2(v1[2][q], v1[3][q]); *(LAS u32x2*)(vb + (c8 * 8 + 4 + q) * VT_STRIDE + s4 * 8) = o2; } }
        __syncthreads();
        f32x4 acc[2][8];
#pragma unroll
        for (int tb = 0; tb < 2; ++tb)
#pragma unroll
            for (int cb = 0; cb < 8; ++cb) acc[tb][cb] = (f32x4){0.f, 0.f, 0.f, 0.f};
#pragma unroll
        for (int cb = 0; cb < 8; ++cb)
#pragma unroll
            for (int kk = 0; kk < 4; ++kk) { const bf16x8 af = *(const LAS bf16x8*)(vb + (cb * 16 + fr) * VT_STRIDE + (kk * 32 + fq * 8) * 2);
                acc[0][cb] = __builtin_amdgcn_mfma_f32_16x16x32_bf16(af, wf[0][kk], acc[0][cb], 0, 0, 0);
                acc[1][cb] = __builtin_amdgcn_mfma_f32_16x16x32_bf16(af, wf[1][kk], acc[1][cb], 0, 0, 0); }
#pragma unroll
        for (int tb = 0; tb < 2; ++tb) { const int tg = t0 + (wv + 4 * tb) * 16 + fr;
#pragma unroll
            for (int cb = 0; cb < 8; ++cb) { const size_t off = (size_t)tg * SW + g * 128 + cb * 16 + fq * 4; const u32x2 uw = uws[tb][cb];
                u32x2 o; o.x = pk2(__uint_as_float(uw.x << 16) * (acc[tb][cb][0] + bias[tb]), __uint_as_float(uw.x & 0xffff0000u) * (acc[tb][cb][1] + bias[tb]));
                o.y = pk2(__uint_as_float(uw.y << 16) * (acc[tb][cb][2] + bias[tb]), __uint_as_float(uw.y & 0xffff0000u) * (acc[tb][cb][3] + bias[tb]));
                *(u32x2*)(SB + off) = o; } }
    }
    __syncthreads();
}

constexpr int RP_STRIDE = 52;
DEV void split8(const f32x4 a0, const f32x4 a1, bf16x8& hi, bf16x8& lo) {
    u32x4 h; h.x = pk2(a0[0], a0[1]); h.y = pk2(a0[2], a0[3]); h.z = pk2(a1[0], a1[1]); h.w = pk2(a1[2], a1[3]);
    f32x4 r0, r1; pg8::unpack8(h, r0, r1); r0 = a0 - r0; r1 = a1 - r1;
    u32x4 l; l.x = pk2(r0[0], r0[1]); l.y = pk2(r0[2], r0[3]); l.z = pk2(r1[0], r1[1]); l.w = pk2(r1[2], r1[3]);
    hi = __builtin_bit_cast(bf16x8, h); lo = __builtin_bit_cast(bf16x8, l);
}
DEV void router_group(LAS unsigned char* lds, const bf16_t* x1, const bf16_t* WRh, const bf16_t* WRl, const float* b_rg, const float* b_re,
                      float* ew, float* rstd_out, int* cnt, int* list, int grp, int tid) {
    const int lane = tid & 63, wave = __builtin_amdgcn_readfirstlane(tid >> 6), fr = lane & 15, fq = lane >> 4;
    LAS float* part = (LAS float*)lds;
    LAS float* ssb = (LAS float*)(lds + 8 * 64 * RP_STRIDE * 4);
    LAS int* hist = (LAS int*)(lds + 8 * 64 * RP_STRIDE * 4 + 2048);
    LAS int* base = hist + 32;
    const int row0 = grp * 64;
    if (tid < 32) hist[tid] = 0;
    f32x4 acc[4][3]; float ssp[4];
#pragma unroll
    for (int rb = 0; rb < 4; ++rb) { ssp[rb] = 0.f;
#pragma unroll
        for (int nb = 0; nb < 3; ++nb) acc[rb][nb] = (f32x4){0.f, 0.f, 0.f, 0.f}; }
#pragma unroll 4
    for (int ks = 0; ks < 8; ++ks) { const int k0 = wave * 256 + ks * 32 + fq * 8;
        bf16x8 bh[3], bl[3];
#pragma unroll
        for (int nb = 0; nb < 3; ++nb) { bh[nb] = *(const bf16x8*)(WRh + (size_t)(nb * 16 + fr) * D + k0); bl[nb] = *(const bf16x8*)(WRl + (size_t)(nb * 16 + fr) * D + k0); }
        u32x4 xa[4];
#pragma unroll
        for (int rb = 0; rb < 4; ++rb) xa[rb] = *(const u32x4*)(x1 + (size_t)(row0 + rb * 16 + fr) * D + k0);
#pragma unroll
        for (int rb = 0; rb < 4; ++rb) { f32x4 a0, a1; pg8::unpack8(xa[rb], a0, a1);
            ssp[rb] += ((a0[0] * a0[0] + a0[1] * a0[1]) + (a0[2] * a0[2] + a0[3] * a0[3])) + ((a1[0] * a1[0] + a1[1] * a1[1]) + (a1[2] * a1[2] + a1[3] * a1[3]));
            const bf16x8 ah = __builtin_bit_cast(bf16x8, xa[rb]);
#pragma unroll
            for (int nb = 0; nb < 3; ++nb) { acc[rb][nb] = __builtin_amdgcn_mfma_f32_16x16x32_bf16(ah, bh[nb], acc[rb][nb], 0, 0, 0);
                acc[rb][nb] = __builtin_amdgcn_mfma_f32_16x16x32_bf16(ah, bl[nb], acc[rb][nb], 0, 0, 0); } }
    }
    LAS float* pw = part + wave * 64 * RP_STRIDE;
#pragma unroll
    for (int rb = 0; rb < 4; ++rb) { float v = ssp[rb]; v += __shfl_xor(v, 16); v += __shfl_xor(v, 32); if (fq == 0) ssb[wave * 64 + rb * 16 + fr] = v;
#pragma unroll
        for (int nb = 0; nb < 3; ++nb)
#pragma unroll
            for (int q = 0; q < 4; ++q) pw[(rb * 16 + 4 * fq + q) * RP_STRIDE + nb * 16 + fr] = acc[rb][nb][q]; }
    __syncthreads();
    int e0 = 0, e1 = 0, lr0 = 0, lr1 = 0; float w0 = 0.f, w1 = 0.f;
    if (tid < 64) { const int r = tid;
        float ss = 0.f;
#pragma unroll
        for (int w = 0; w < 8; ++w) ss += ssb[w * 64 + r];
        const float rstd = rsqrtf(ss * (1.f / D) + EPS);
        rstd_out[row0 + r] = rstd;
        float gl[4];
#pragma unroll
        for (int o = 0; o < 4; ++o) { float sacc = 0.f;
#pragma unroll
            for (int w = 0; w < 8; ++w) sacc += part[(w * 64 + r) * RP_STRIDE + o];
            gl[o] = sacc * rstd + b_rg[o]; }
        float best = gl[0]; int gi = 0;
#pragma unroll
        for (int o = 1; o < 4; ++o) if (gl[o] > best) { best = gl[o]; gi = o; }
        float se = 0.f;
#pragma unroll
        for (int o = 0; o < 4; ++o) se += __expf(gl[o] - best);
        const float gp = 1.f / se;
        float l0 = -3.0e38f, l1 = -3.0e38f; int i0 = 0, i1 = 0;
        for (int o = 0; o < 8; ++o) { float sacc = 0.f;
#pragma unroll
            for (int w = 0; w < 8; ++w) sacc += part[(w * 64 + r) * RP_STRIDE + 4 + gi * 8 + o];
            const float sv = sacc * rstd + b_re[gi * 8 + o];
            if (sv > l0) { l1 = l0; i1 = i0; l0 = sv; i0 = o; } else if (sv > l1) { l1 = sv; i1 = o; } }
        const float e = __expf(l1 - l0);
        w0 = gp / (1.f + e); w1 = gp * e / (1.f + e); e0 = gi * 8 + i0; e1 = gi * 8 + i1;
        lr0 = atomicAdd((int*)(hist + e0), 1); lr1 = atomicAdd((int*)(hist + e1), 1);
    }
    __syncthreads();
    if (tid < 32) { const int n = hist[tid]; base[tid] = n ? atomicAdd(cnt + tid, n) : 0; }
    __syncthreads();
    if (tid < 64) { const int t = row0 + tid; ew[2 * t] = w0; ew[2 * t + 1] = w1;
        list[e0 * CAP + base[e0] + lr0] = 2 * t; list[e1 * CAP + base[e1] + lr1] = 2 * t + 1; }
    __syncthreads();
}

constexpr int NWAVES = 8;
constexpr int RING_OFF = 0, RING_BYTES = 131072;
constexpr int LDSCTL_OFF = RING_BYTES, MISC_OFF = LDSCTL_OFF + 320;
constexpr int LDS_BYTES = 147456;
constexpr int CW_BAR = 4096;
constexpr size_t WS_PU = 550 * MiB;
constexpr size_t WS_END2 = 614 * MiB;
constexpr int N_PHASES = 10;

struct Args { const float* in[28]; float* out; unsigned char* ws; int ph_lo, ph_hi, li, pad; };

DEV void moe_tables(LAS int* pre, LAS int* cl, const int* cnt, int tid) {
    if (tid == 0) { int a = 0; for (int e = 0; e < 32; ++e) { const int n = cnt[e]; cl[e] = n; pre[e] = a; a += (n + 255) >> 8; } pre[32] = a; }
    __syncthreads();
}

__global__ void __launch_bounds__(NWAVES * 64, 2) mk_fwd(Args args) {
    extern __shared__ __attribute__((aligned(16))) unsigned char lds_raw[];
    LAS unsigned char* lds = (LAS unsigned char*)lds_raw;
    volatile LAS unsigned* MISC = (volatile LAS unsigned*)(lds + MISC_OFF);
    const int G = gridDim.x; const int bx = blockIdx.x;
    const int wave_s = __builtin_amdgcn_readfirstlane(threadIdx.x >> 6);
    for (int u = threadIdx.x; u < (LDS_BYTES - LDSCTL_OFF) / 4; u += NWAVES * 64) ((LAS unsigned*)(lds + LDSCTL_OFF))[u] = 0u;
    __syncthreads();
    const int lo = args.ph_lo, hi = args.ph_hi;
    XcdBarrier bar; bar.bar = (unsigned*)(args.ws + WS_CTL) + CW_BAR + args.li * XCD_BAR_WORDS; bar.x = 0; bar.st = nullptr;
    if (hi - lo > 1) bar = xcd_barrier_post((unsigned*)(args.ws + WS_CTL) + CW_BAR + args.li * XCD_BAR_WORDS, MISC + 8);
#ifndef PH_EN
#define PH_EN 0x3FF
#endif
#ifndef REPEAT_PH
#define REPEAT_PH -1
#endif
#define IN(k) (((PH_EN >> (k)) & 1) && lo <= (k) && (k) < hi)
#ifndef SEAM_REPS
#define SEAM_REPS 1
#endif
#define SEAM(k) do { if (IN(k) && IN((k) + 1)) { for (int sr_ = 0; sr_ < SEAM_REPS; ++sr_) xcd_barrier(bar, wave_s); } } while (0)
#define REPS(k) (((k) == REPEAT_PH) ? 2 : 1)
#define PHASE_BEGIN \
    int tid; asm volatile("v_mbcnt_lo_u32_b32 %0, -1, 0\n\tv_mbcnt_hi_u32_b32 %0, -1, %0" : "=v"(tid)); tid += wave_s * 64; \
    const __attribute__((address_space(4))) Args* ap = (const __attribute__((address_space(4))) Args*)__builtin_amdgcn_kernarg_segment_ptr(); asm volatile("" : "+s"(ap)); \
    unsigned char* ws = ap->ws; float* out = ap->out; \
    const int lane = tid & 63, wave = __builtin_amdgcn_readfirstlane(tid >> 6); \
    const int vcu = (G % 8 == 0) ? (bx % 8) * (G / 8) + bx / 8 : bx; const int gw = vcu * NWAVES + wave, NGW = G * NWAVES; \
    (void)lane; (void)wave; (void)gw; (void)NGW; (void)ws; (void)out;
#define WSP(T_, off) ((T_*)(ws + (off)))
    LAS int* pre = (LAS int*)(lds + LDSCTL_OFF + 1024); LAS int* cl = pre + 64;

    for (int rep_ = 0; rep_ < REPS(0); ++rep_) { if (rep_) xcd_barrier(bar, wave_s);
    if (IN(0)) { PHASE_BEGIN
        bf16_t* W1t = WSP(bf16_t, WS_W1T);
        constexpr int NITEMS = (D / 64) * (NIN / 64) + (D / 64) * (2 * D / 64) + 2 * (PW / 64) * (D / 64) + (D / 64) * (D / 64);
#define DEC_P0(r_in, d) do { int r = (r_in); \
            if (item_try(r, d, ap->in[3], D, PW, 1, 0, 0, W1t, 0, 0, ap->in[2], 1.f, 0, NIN)) break;     \
            if (item_try(r, d, ap->in[3] + PW, D, 2 * SW, 1, 0, 0, WSP(bf16_t, WS_WMGQ), 0, 0, ap->in[2], WGU_SCALE, 1, NIN)) break;     \
            if (item_try(r, d, ap->in[12], D, 2 * D, 1, 0, 0, WSP(bf16_t, WS_WMGQ), 0, 2 * SW, ap->in[2], WGU_SCALE, 1)) break;     \
            if (item_try(r, d, ap->in[6], PW, D, 1, 0, 0, WSP(bf16_t, WS_WAT), 0, 0, nullptr, 1.f, 0)) break; \
            if (item_try(r, d, ap->in[11], SW, D, 1, 0, 0, WSP(bf16_t, WS_WBT), 0, 0, nullptr, 1.f, 0)) break; \
            item_try(r, d, ap->in[14], D, D, 1, 0, 0, WSP(bf16_t, WS_WOT), 0, 0, nullptr, 1.f, 0); } while (0)
        { const int ch = (NITEMS + NGW - 1) / NGW, lo_ = gw * ch, hi_ = (lo_ + ch) < NITEMS ? (lo_ + ch) : NITEMS;
          ITEM_STREAM(DEC_P0, lo_, 1, hi_, lane); }
#undef DEC_P0
        { const float *wp = ap->in[4], *ps = ap->in[5]; bf16_t* WPS = WSP(bf16_t, WS_WPS); for (int i = bx * 512 + tid; i < 4 * 256 * 256; i += G * 512) WPS[i] = f2bf(wp[i] * ps[(i >> 16) * 256 + (i & 255)]); }
        { const float* wsp = ap->in[9]; bf16_t* WSb = WSP(bf16_t, WS_WSB); for (int i = bx * 512 + tid; i < 8 * 128 * 128; i += G * 512) { const int sidx = i & 127, t = (i >> 7) & 127; WSb[i] = f2bf(((sidx >> 6) <= (t >> 6)) ? wsp[i] : 0.f); } }
        { const float *wrg = ap->in[16], *wre = ap->in[18], *gf = ap->in[15]; bf16_t *WRh = WSP(bf16_t, WS_WRH), *WRl = WSP(bf16_t, WS_WRL);
          for (int i = bx * 512 + tid; i < 48 * D; i += G * 512) { const int o = i / D, k = i % D; float w = 0.f;
              if (o < 4) w = wrg[k * 4 + o]; else if (o < 36) w = wre[((size_t)((o - 4) >> 3) * D + k) * 8 + ((o - 4) & 7)];
              w *= gf[k]; const bf16_t h = f2bf(w); WRh[i] = h; WRl[i] = f2bf(w - bf2f(h)); } }
        { const float* x = ap->in[0]; bf16_t* XN = WSP(bf16_t, WS_XN); unsigned char* XNQ = WSP(unsigned char, WS_XNQ); float* rs0 = WSP(float, WS_RSTD0);
          for (int m = gw; m < T; m += NGW) rms_row_q(x + (size_t)m * D, XN + (size_t)m * D, XNQ + (size_t)m * D, rs0 + m, lane); }
    }
    }
    SEAM(0);
    for (int rep_ = 0; rep_ < REPS(1); ++rep_) { if (rep_) xcd_barrier(bar, wave_s);
    if (IN(1)) {
        const int p = (bx >> 3) & 7;
#define P1_Z(i0_, i1_) { PHASE_BEGIN \
          pg8::SchedDense S{D * 2u, D * 2u, T / 256, PW / 256, G, bx, (i0_), (i1_)}; \
          pg8::EpiP1 E{WSP(bf16_t, WS_AIN), WSP(bf16_t, WS_UU), WSP(bf16_t, WS_GV), WSP(bf16_t, WS_GATES), ap->in[13], 1.f, WSP(float, WS_RSTD0), WSP(float, WS_LNS)}; \
          pg8::gemm_phase<pg8::EpiP1, pg8::SchedDense, true, false>(lds + RING_OFF, WSP(const char, WS_XN), WSP(const char, WS_W1T), D * 2u, D * 2u, D / 64, 0, S, E, tid); }
#define P1_G(i0_, i1_) { PHASE_BEGIN \
          pg8::SchedDense S{(unsigned)D, (unsigned)D, T / 256, (2 * SW + 2 * D) / 256, G, bx, (i0_), (i1_), PW / 256}; \
          pg8::EpiP1 E{WSP(bf16_t, WS_AIN), WSP(bf16_t, WS_UU), WSP(bf16_t, WS_GV), WSP(bf16_t, WS_GATES), ap->in[13], 1.f / WGU_SCALE, WSP(float, WS_RSTD0), WSP(float, WS_LNS)}; \
          pg8::gemm_phase<pg8::EpiP1, pg8::SchedDense, true, false, true>(lds + RING_OFF, WSP(const char, WS_XNQ), WSP(const char, WS_WMGQ), (unsigned)D, (unsigned)D, D / 128, 0, S, E, tid); }
#define P1_SLOT() { PHASE_BEGIN \
          constexpr int NX = 2 * NE * (D / 64) * (DE / 64) + NE * (DE / 64) * (D / 64);     \
          int lo_, hi_; \
          if (G == 256) {     \
              const int x_ = vcu >> 5, k_ = vcu & 31; constexpr int CHS = 10, NS = 8 * 4 * NWAVES, NR = 256 * NWAVES - NS, BASE = (NX - NS * CHS) / NR, EXTRA = (NX - NS * CHS) % NR; \
              if (k_ < 4) { lo_ = ((x_ * 4 + k_) * NWAVES + wave) * CHS; hi_ = lo_ + CHS; } \
              else { const int w_ = (x_ * 28 + (k_ - 4)) * NWAVES + wave; lo_ = NS * CHS + w_ * BASE + (w_ < EXTRA ? w_ : EXTRA); hi_ = lo_ + BASE + (w_ < EXTRA ? 1 : 0); } \
          } else { const int ch = (NX + NGW - 1) / NGW; lo_ = gw * ch; hi_ = (lo_ + ch) < NX ? (lo_ + ch) : NX; } \
          ITEM_STREAM(DEC_X, lo_, 1, hi_, lane); \
          VM_WAIT(); __syncthreads(); }
#define DEC_X(r_in, d) do { int r = (r_in); \
          if (item_try(r, d, ap->in[20], D, DE, NE, (long)D * DE, (long)1024 * D, WSP(bf16_t, WS_WGUT), 1, 0, ap->in[15], WGU_SCALE, 3)) break;     \
          if (item_try(r, d, ap->in[21], D, DE, NE, (long)D * DE, (long)1024 * D, WSP(bf16_t, WS_WGUT), 2, 0, ap->in[15], WGU_SCALE, 3)) break; \
          item_try(r, d, ap->in[22], DE, D, NE, (long)DE * D, (long)D * DE, WSP(bf16_t, WS_WDT), 0, 0, nullptr, WD_SCALE, 3); } while (0)
        if (bx < 32) { PHASE_BEGIN
          const int g = bx >> 3, pm = bx & 7;
          pg8::SchedOne S; S.u0.A = (unsigned)(((size_t)pm * 256 * PW + g * 256) * 2); S.u0.B = (unsigned)g * 65536u * 2u; S.u0.rows = nullptr; S.u0.pm = pm; S.u0.pn = g; S.u0.flags = 0; S.u0.mvalid = 256;
          pg8::EpiBf16S E{WSP(bf16_t, WS_W2T), PW, nullptr};
          pg8::gemm_phase<pg8::EpiBf16S, pg8::SchedOne, true, false>(lds + RING_OFF, WSP(const char, WS_WAT), WSP(const char, WS_WPS), PW * 2u, 256 * 2u, 4, 0, S, E, tid); }
        if (p == 0) { P1_SLOT() P1_Z(0, 1 << 30) P1_G(0, 1 << 30) }
        else { P1_Z(0, 1 << 30) P1_G(0, p - 1) P1_SLOT() P1_G(p - 1, 1 << 30) }
#undef P1_Z
#undef P1_G
#undef P1_SLOT
#undef DEC_X
    }
    }
    SEAM(1);
    for (int rep_ = 0; rep_ < REPS(2); ++rep_) { if (rep_) xcd_barrier(bar, wave_s);
    if (IN(2)) {
        for (int L = bx; L < (T / 256) * 4; L += G) { PHASE_BEGIN
            const int pm = L >> 2, g = L & 3;
            bf16_t* ZP = (bf16_t*)out;
            zp_block(WSP(bf16_t, WS_AIN), ZP, pm, g, tid); }
        for (int L = bx; L < (T / 128) * 2; L += G) { PHASE_BEGIN
            bf16_t* SB = (bf16_t*)out + (size_t)2 * T * PW;
            sgu_unit(lds + RING_OFF, WSP(float, WS_LNS), WSP(bf16_t, WS_GV), WSP(bf16_t, WS_UU), WSP(bf16_t, WS_WSB), ap->in[10], ap->in[7], ap->in[8], SB, L >> 1, L & 1, tid); }
    }
    }
    SEAM(2);
    for (int rep_ = 0; rep_ < REPS(3); ++rep_) { if (rep_) xcd_barrier(bar, wave_s);
    if (IN(3)) {
        { PHASE_BEGIN
          const char* ZPc = (const char*)out;
          pg8::SchedDual S{(unsigned)((size_t)2 * T * PW * 2), (unsigned)(WS_WBT - WS_W2T), PW * 2u, PW * 2u, T / 256, D / 256, G, bx};
          pg8::EpiMerge E{WSP(unsigned char, WS_GATES), WSP(bf16_t, WS_MG)};
          pg8::gemm_phase<pg8::EpiMerge, pg8::SchedDual, true, false>(lds + RING_OFF, ZPc, WSP(const char, WS_W2T), PW * 2u, PW * 2u, PW / 64, 0, S, E, tid); }
    }
    }
    SEAM(3);
    for (int rep_ = 0; rep_ < REPS(4); ++rep_) { if (rep_) xcd_barrier(bar, wave_s);
    if (IN(4)) { PHASE_BEGIN
        pg8::SchedDense S{D * 2u, D * 2u, T / 256, D / 256, G, bx};
        pg8::EpiResBf16 E{WSP(bf16_t, WS_XN), (unsigned char*)out};
        pg8::gemm_phase<pg8::EpiResBf16, pg8::SchedDense, true, false>(lds + RING_OFF, WSP(const char, WS_MG), WSP(const char, WS_WOT), D * 2u, D * 2u, D / 64, 0, S, E, tid);
    }
    }
    SEAM(4);
    if (IN(5)) {
        { PHASE_BEGIN
          constexpr int NI5 = (D / 64) * (D / 64) + (PLE / 64) * (D / 64);
#define DEC_P5(r_in, d) do { int r = (r_in); \
            if (item_try(r, d, ap->in[24], D, D, 1, 0, 0, WSP(bf16_t, WS_WPGT), 0, 0, ap->in[23], WGU_SCALE, 1)) break;     \
            item_try(r, d, ap->in[26], PLE, D, 1, 0, 0, WSP(bf16_t, WS_WPUT), 0, 0, nullptr, 1.f, 0); } while (0)
          { const int ch = (NI5 + NGW - 1) / NGW, lo_ = gw * ch, hi_ = (lo_ + ch) < NI5 ? (lo_ + ch) : NI5;
            ITEM_STREAM(DEC_P5, lo_, 1, hi_, lane); }
#undef DEC_P5
          { const float* pin = ap->in[1]; bf16_t* PB = WSP(bf16_t, WS_PB); for (long i = (long)(bx * 512 + tid) * 4; i < (long)T * PLE; i += (long)G * 512 * 4) { const f32x4 v = __builtin_nontemporal_load((const f32x4*)(pin + i)); u32x2 o; o.x = pk2(v[0], v[1]); o.y = pk2(v[2], v[3]); *(u32x2*)(PB + i) = o; } }
        }
        for (int grp = bx; grp < T / 64; grp += G) { PHASE_BEGIN
            router_group(lds + RING_OFF, WSP(bf16_t, WS_XN), WSP(bf16_t, WS_WRH), WSP(bf16_t, WS_WRL), ap->in[17], ap->in[19], WSP(float, WS_EW), WSP(float, WS_RSTD), WSP(int, WS_CTL), WSP(int, WS_LIST), grp, tid); }
    }
    SEAM(5);
    for (int rep_ = 0; rep_ < REPS(6); ++rep_) { if (rep_) xcd_barrier(bar, wave_s);
    if (IN(6)) { PHASE_BEGIN
        moe_tables(pre, cl, WSP(int, WS_CTL), tid);
        pg8::SchedMoe S{1024u * D, (unsigned)D, WSP(int, WS_LIST), pre, cl, 4, G, vcu, WSP(unsigned, WS_MOERDY), 1, wave};
        pg8::EpiMoe1 E{WSP(unsigned char, WS_HID), WSP(float, WS_RSTD)};
        pg8::gemm_phase<pg8::EpiMoe1, pg8::SchedMoe, true, true, true>(lds + RING_OFF, out, WSP(const char, WS_WGUT), (unsigned)D, (unsigned)D, D / 128, 1, S, E, tid);
    }
    }
    for (int rep_ = 0; rep_ < REPS(7); ++rep_) { if (rep_) xcd_barrier(bar, wave_s);
    if (IN(7)) { PHASE_BEGIN
        if (!IN(6)) moe_tables(pre, cl, WSP(int, WS_CTL), tid);
        const int r1 = (__builtin_amdgcn_readfirstlane(pre[32]) * 4) % G;
        pg8::SchedMoe S{(unsigned)D * DE, (unsigned)DE, WSP(int, WS_LIST), pre, cl, 8, G, vcu, WSP(unsigned, WS_MOERDY), 2, wave, r1, 2};
        pg8::EpiMoe2 E{WSP(unsigned char, WS_Y), WSP(float, WS_EW)};
        pg8::gemm_phase<pg8::EpiMoe2, pg8::SchedMoe, true, true, true>(lds + RING_OFF, WSP(const char, WS_HID), WSP(const char, WS_WDT), (unsigned)DE, (unsigned)DE, DE / 128, 0, S, E, tid);
    }
    }
    SEAM(7);
    if (IN(8)) { PHASE_BEGIN
        const unsigned char* Y = WSP(unsigned char, WS_Y); bf16_t *XB = WSP(bf16_t, WS_XN), *X2 = WSP(bf16_t, WS_X2B); unsigned char* X2Q = WSP(unsigned char, WS_X2Q); float* rs2 = WSP(float, WS_RSTD2);
        for (int m = gw; m < T; m += NGW) x2_row(XB + (size_t)m * D, Y + (size_t)(2 * m) * D, Y + (size_t)(2 * m + 1) * D, X2 + (size_t)m * D, X2Q + (size_t)m * D, rs2 + m, lane);
        VM_WAIT(); __syncthreads();
        {
          pg8::SchedDense S{PLE * 2u, PLE * 2u, T / 256, D / 256, G, bx};
          pg8::EpiBf16S E{WSP(bf16_t, WS_PU), D, nullptr, 1};
          pg8::gemm_phase<pg8::EpiBf16S, pg8::SchedDense, true, false>(lds + RING_OFF, WSP(const char, WS_PB), WSP(const char, WS_WPUT), PLE * 2u, PLE * 2u, PLE / 64, 0, S, E, tid); }
    }
    SEAM(8);
    if (IN(9)) { PHASE_BEGIN
        pg8::SchedPanel S{(unsigned)D, (unsigned)D, T / 256, G, vcu};
        pg8::EpiPleFinal E{WSP(bf16_t, WS_X2B), WSP(float, WS_RSTD2), ap->in[25], WSP(bf16_t, WS_PU), ap->in[27], out, WSP(float, WS_SSQ), WSP(unsigned, WS_PCNT)};
        pg8::gemm_phase<pg8::EpiPleFinal, pg8::SchedPanel, true, false, true>(lds + RING_OFF, WSP(const char, WS_X2Q), WSP(const char, WS_WPGT), (unsigned)D, (unsigned)D, D / 128, 0, S, E, tid);
    }
#undef IN
#undef SEAM
}


static int g_grid = 0;
extern "C" void kernel_launch(void* const* d_in, const int* in_sizes, int n_in, void* d_out, int out_size, void* d_ws, size_t ws_size, hipStream_t stream) {
    if (g_grid == 0) {
        if (n_in != 28 || in_sizes[0] != T * D || out_size != T * D || ws_size < WS_END2) { fprintf(stderr, "kernel_launch: unexpected shapes (n_in %d, in0 %d, out %d, ws %zu)\n", n_in, n_in > 0 ? in_sizes[0] : -1, out_size, ws_size); g_grid = -1; return; }
        int dev = 0, cus = 0, per_cu = 0;
        if (hipGetDevice(&dev) != hipSuccess || hipDeviceGetAttribute(&cus, hipDeviceAttributeMultiprocessorCount, dev) != hipSuccess) { fprintf(stderr, "kernel_launch: device query failed\n"); g_grid = -1; return; }
        if (hipFuncSetAttribute((const void*)mk_fwd, hipFuncAttributeMaxDynamicSharedMemorySize, LDS_BYTES) != hipSuccess) { fprintf(stderr, "kernel_launch: hipFuncSetAttribute failed\n"); g_grid = -1; return; }
        if (hipOccupancyMaxActiveBlocksPerMultiprocessor(&per_cu, (const void*)mk_fwd, NWAVES * 64, LDS_BYTES) != hipSuccess || per_cu < 1) { fprintf(stderr, "kernel_launch: occupancy query says %d workgroups per CU\n", per_cu); g_grid = -1; return; }
        g_grid = cus & ~7;
        if (g_grid < 8) { fprintf(stderr, "kernel_launch: %d CUs?\n", cus); g_grid = -1; return; }
    }
    if (g_grid < 0) return;
    (void)hipMemsetAsync((unsigned char*)d_ws + WS_CTL, 0, 1 * MiB, stream);
    Args a{};
    for (int i = 0; i < 28; ++i) a.in[i] = (const float*)d_in[i];
    a.out = (float*)d_out; a.ws = (unsigned char*)d_ws; a.ph_lo = 0; a.ph_hi = N_PHASES; a.li = 0; a.pad = 0;
#ifndef SPLIT_REPEAT
#define SPLIT_REPEAT 1
#endif
#ifdef SPLIT_AT
    a.ph_hi = SPLIT_AT + SPLIT_REPEAT;
    hipLaunchKernelGGL(mk_fwd, dim3(g_grid), dim3(NWAVES * 64), LDS_BYTES, stream, a);
    a.ph_lo = SPLIT_AT; a.ph_hi = N_PHASES; a.li = 1;
    if (SPLIT_AT == 5) (void)hipMemsetAsync((unsigned char*)d_ws + WS_CTL, 0, 128, stream);
#endif
    hipLaunchKernelGGL(mk_fwd, dim3(g_grid), dim3(NWAVES * 64), LDS_BYTES, stream, a);
#ifdef RUN_TWICE
    (void)hipMemsetAsync((unsigned char*)d_ws + WS_CTL, 0, 1 * MiB, stream);
    hipLaunchKernelGGL(mk_fwd, dim3(g_grid), dim3(NWAVES * 64), LDS_BYTES, stream, a);
#endif
}
```
